# Optimizing an MI355X kernel written in HIP

```python
import jax, jax.numpy as jnp
from jax import lax
import numpy as np

D_MODEL = 1024
BATCH = 2
SEQ = 16384
DEPTH = 2
DEC_BATCH = 16
DEC_SEQ = 16
PAST_LEN = 1024

CHUNK = 64
GDN_HEADS = 4
GDN_HEAD_DIM = 128
GDN_WIDTH = GDN_HEADS * GDN_HEAD_DIM
SC_WIDTH = D_MODEL - GDN_WIDTH
GDN_CONV = 4
SC_CONV = 3
D_FF = -(-8 * D_MODEL // (3 * 256)) * 256
EPS = 1e-6
OFF_QKV = 3 * GDN_WIDTH
OFF_Z = OFF_QKV + GDN_WIDTH
OFF_B = OFF_Z + GDN_HEADS
OFF_A = OFF_B + GDN_HEADS
OFF_SB = OFF_A + SC_WIDTH
OFF_SC = OFF_SB + SC_WIDTH
IN_DIM = OFF_SC + SC_WIDTH

kernel_name = 'hybrid_gdn_shortconv_stream_step'


def rmsnorm(x, g):
    xf = x.astype(jnp.float32)
    y = xf * lax.rsqrt(jnp.mean(xf * xf, axis=-1, keepdims=True) + EPS)
    return (y * g.astype(jnp.float32)).astype(x.dtype)


def l2norm(x):
    return x * lax.rsqrt(jnp.sum(x * x, axis=-1, keepdims=True) + EPS)


def causal_dwconv(x, prev, w):
    width = w.shape[0]
    L = x.shape[1]
    xp = jnp.concatenate([prev.astype(x.dtype), x], axis=1)
    y = xp[:, 0:L] * w[0]
    for i in range(1, width):
        y = y + xp[:, i:i + L] * w[i]
    return y, xp[:, xp.shape[1] - (width - 1):]


def gated_delta_rule(q, k, v, g, beta, S0, chunk):
    B, L, H, DK = q.shape
    DV = v.shape[-1]
    N = L // chunk

    def blk(t):
        return jnp.moveaxis(t.reshape((B, N, chunk, H) + t.shape[3:]), 3, 2)

    q, k, v, beta = blk(q), blk(k), blk(v), blk(beta)
    g = jnp.cumsum(blk(g), axis=-1)
    idx = jnp.arange(chunk)
    causal = idx[:, None] >= idx[None, :]
    strict = idx[:, None] > idx[None, :]
    decay = jnp.exp(jnp.where(causal, g[..., :, None] - g[..., None, :], -jnp.inf))
    kb = k * beta[..., None]
    A = jnp.where(strict, jnp.einsum('bnhid,bnhjd->bnhij', kb, k) * decay, 0.0)
    eye = jnp.eye(chunk, dtype=jnp.float32)
    rhs = jnp.concatenate([v * beta[..., None], kb * jnp.exp(g)[..., None]], axis=-1)
    sol = lax.linalg.triangular_solve(eye + A, rhs, left_side=True, lower=True, unit_diagonal=True)
    u, w = sol[..., :DV], sol[..., DV:]
    qk = jnp.einsum('bnhid,bnhjd->bnhij', q, k) * decay
    qg = q * jnp.exp(g)[..., None]
    g_last = g[..., -1]
    k_tail = k * jnp.exp(g_last[..., None] - g)[..., None]
    a_last = jnp.exp(g_last)

    def step(S, xs):
        qg_c, qk_c, u_c, w_c, kt_c, al_c = xs
        v_new = u_c - jnp.einsum('bhcd,bhde->bhce', w_c, S)
        o = jnp.einsum('bhcd,bhde->bhce', qg_c, S) + jnp.einsum('bhij,bhje->bhie', qk_c, v_new)
        S = S * al_c[..., None, None] + jnp.einsum('bhcd,bhce->bhde', kt_c, v_new)
        return S, o

    xs = tuple(jnp.moveaxis(t, 1, 0) for t in (qg, qk, u, w, k_tail, a_last))
    S, o = lax.scan(step, S0.astype(jnp.float32), xs)
    o = o.transpose(1, 0, 3, 2, 4).reshape(B, L, H, DV)
    return o, S


def hybrid_layer(x, conv_prev, S0, sc_prev, norm_mix_pre, w_in, conv_qkv_w, a_log, dt_bias,
                 gdn_norm_w, conv_sc_w, w_o, norm_mix_post, norm_ffn_pre, w_gate, w_up, w_down,
                 norm_ffn_post):
    B, L, _ = x.shape
    chunk = min(CHUNK, L)
    h = rmsnorm(x, norm_mix_pre)
    P = h @ w_in
    qkv_in = P[..., :OFF_QKV]
    z = P[..., OFF_QKV:OFF_Z]
    b_raw = P[..., OFF_Z:OFF_B].astype(jnp.float32)
    a_raw = P[..., OFF_B:OFF_A].astype(jnp.float32)
    sc_b = P[..., OFF_A:OFF_SB]
    sc_c = P[..., OFF_SB:OFF_SC]
    sc_h = P[..., OFF_SC:]

    qkv, conv_new = causal_dwconv(qkv_in, conv_prev, conv_qkv_w)
    qkv = jax.nn.silu(qkv.astype(jnp.float32))
    q = l2norm(qkv[..., :GDN_WIDTH].reshape(B, L, GDN_HEADS, GDN_HEAD_DIM)) * (GDN_HEAD_DIM ** -0.5)
    k = l2norm(qkv[..., GDN_WIDTH:2 * GDN_WIDTH].reshape(B, L, GDN_HEADS, GDN_HEAD_DIM))
    v = qkv[..., 2 * GDN_WIDTH:].reshape(B, L, GDN_HEADS, GDN_HEAD_DIM)
    beta = jax.nn.sigmoid(b_raw)
    g = -jnp.exp(a_log.astype(jnp.float32)) * jax.nn.softplus(a_raw + dt_bias.astype(jnp.float32))
    o, S_new = gated_delta_rule(q, k, v, g, beta, S0, chunk)
    zf = z.astype(jnp.float32).reshape(B, L, GDN_HEADS, GDN_HEAD_DIM)
    o = (rmsnorm(o, gdn_norm_w) * jax.nn.silu(zf)).reshape(B, L, GDN_WIDTH).astype(x.dtype)

    sc_y, sc_new = causal_dwconv(sc_c * sc_h, sc_prev, conv_sc_w)
    sc_out = sc_b * sc_y

    mix = jnp.concatenate([o, sc_out.astype(x.dtype)], axis=-1) @ w_o
    x = x + rmsnorm(mix, norm_mix_post)

    h = rmsnorm(x, norm_ffn_pre)
    f = (jax.nn.silu(h @ w_gate) * (h @ w_up)) @ w_down
    x = x + rmsnorm(f, norm_ffn_post)
    return x, conv_new, S_new, sc_new


def setup_inputs(seed: int = 0) -> dict:
    key = jax.random.key(seed)
    ks = jax.random.split(key, 24)
    f32 = jnp.float32

    def nrm(k, shape, scale):
        return jax.random.normal(k, shape, f32) * scale

    def gain(k, shape):
        return 1.0 + 0.02 * jax.random.normal(k, shape, f32)

    dt = jnp.exp(jax.random.uniform(ks[9], (DEPTH, GDN_HEADS), f32, np.log(1e-3), np.log(1e-1)))
    return {
        'x_prompt': nrm(ks[0], (BATCH, SEQ, D_MODEL), 1.0),
        'x_sample': nrm(ks[1], (DEC_BATCH, DEC_SEQ, D_MODEL), 1.0),
        'cache_gdn_conv': nrm(ks[2], (DEPTH, DEC_BATCH, GDN_CONV - 1, 3 * GDN_WIDTH), 1.0),
        'state_gdn': nrm(ks[3], (DEPTH, DEC_BATCH, GDN_HEADS, GDN_HEAD_DIM, GDN_HEAD_DIM), 0.05),
        'cache_sc_conv': nrm(ks[4], (DEPTH, DEC_BATCH, SC_CONV - 1, SC_WIDTH), 1.0),
        'norm_mix_pre': gain(ks[5], (DEPTH, D_MODEL)),
        'w_in': nrm(ks[6], (DEPTH, D_MODEL, IN_DIM), D_MODEL ** -0.5),
        'conv_qkv_w': nrm(ks[7], (DEPTH, GDN_CONV, 3 * GDN_WIDTH), GDN_CONV ** -0.5),
        'a_log': jnp.log(jax.random.uniform(ks[8], (DEPTH, GDN_HEADS), f32, 1.0, 16.0)),
        'dt_bias': dt + jnp.log(-jnp.expm1(-dt)),
        'gdn_norm_w': gain(ks[10], (DEPTH, GDN_HEAD_DIM)),
        'conv_sc_w': nrm(ks[11], (DEPTH, SC_CONV, SC_WIDTH), SC_CONV ** -0.5),
        'w_o': nrm(ks[12], (DEPTH, D_MODEL, D_MODEL), D_MODEL ** -0.5),
        'norm_mix_post': gain(ks[13], (DEPTH, D_MODEL)),
        'norm_ffn_pre': gain(ks[14], (DEPTH, D_MODEL)),
        'w_gate': nrm(ks[15], (DEPTH, D_MODEL, D_FF), D_MODEL ** -0.5),
        'w_up': nrm(ks[16], (DEPTH, D_MODEL, D_FF), D_MODEL ** -0.5),
        'w_down': nrm(ks[17], (DEPTH, D_FF, D_MODEL), D_FF ** -0.5),
        'norm_ffn_post': gain(ks[18], (DEPTH, D_MODEL)),
    }


def reference(x_prompt, x_sample, cache_gdn_conv, state_gdn, cache_sc_conv, norm_mix_pre, w_in,
              conv_qkv_w, a_log, dt_bias, gdn_norm_w, conv_sc_w, w_o, norm_mix_post, norm_ffn_pre,
              w_gate, w_up, w_down, norm_ffn_post):
    params = (norm_mix_pre, w_in, conv_qkv_w, a_log, dt_bias, gdn_norm_w, conv_sc_w, w_o,
              norm_mix_post, norm_ffn_pre, w_gate, w_up, w_down, norm_ffn_post)

    def run(x, conv0, s0, sc0):
        convs, states, scs = [], [], []
        for l in range(DEPTH):
            x, c, s, sc = hybrid_layer(x, conv0[l], s0[l], sc0[l], *[p[l] for p in params])
            convs.append(c)
            states.append(s)
            scs.append(sc)
        return x, jnp.stack(convs), jnp.stack(states), jnp.stack(scs)

    Bp = x_prompt.shape[0]
    zc = jnp.zeros((DEPTH, Bp, GDN_CONV - 1, 3 * GDN_WIDTH), x_prompt.dtype)
    zs = jnp.zeros((DEPTH, Bp, GDN_HEADS, GDN_HEAD_DIM, GDN_HEAD_DIM), jnp.float32)
    zsc = jnp.zeros((DEPTH, Bp, SC_CONV - 1, SC_WIDTH), x_prompt.dtype)
    y_prompt, conv_p, state_p, sc_p = run(x_prompt, zc, zs, zsc)
    y_sample, conv_s, state_s, sc_s = run(x_sample, cache_gdn_conv, state_gdn, cache_sc_conv)
    return (y_prompt, y_sample, conv_p, state_p, sc_p, conv_s, state_s, sc_s)
```

```cpp
#include <hip/hip_runtime.h>
#include <hip/hip_cooperative_groups.h>
#include <cstdio>
namespace cg = cooperative_groups;

#define LAS __attribute__((address_space(3)))
typedef unsigned short bf16_t;
typedef short bf16x8 __attribute__((ext_vector_type(8)));
typedef float f32x4 __attribute__((ext_vector_type(4)));
typedef float f32x2 __attribute__((ext_vector_type(2)));
typedef unsigned u32x4 __attribute__((ext_vector_type(4)));
typedef unsigned u32x2 __attribute__((ext_vector_type(2)));
typedef __bf16 bf16v2 __attribute__((ext_vector_type(2)));
#define DI __device__ __forceinline__
DI int tid_fresh() { int t = threadIdx.x; asm volatile("" : "+v"(t)); return t; }
DI int bid_fresh() { int b = blockIdx.x; asm volatile("" : "+s"(b)); return b; }
DI unsigned char* ws_fresh(unsigned char* w) { asm volatile("" : "+s"(w)); return w; }

constexpr int DM = 1024, TT = 33024, TP = 32768, DFF = 2816, INDIM = 3592;
constexpr int NCHH = 2112;
constexpr int LDS_BYTES = 147456;

constexpr size_t SZ_WIN = (size_t)3584 * 1024 * 2, SZ_WO = (size_t)1024 * 1024 * 2, SZ_WGU = (size_t)5632 * 1024 * 2, SZ_WD = (size_t)1024 * 2816 * 2;
constexpr size_t OFF_WIN = 0;
constexpr size_t OFF_WO = OFF_WIN + 2 * SZ_WIN;
constexpr size_t OFF_WGU = OFF_WO + 2 * SZ_WO;
constexpr size_t OFF_WD = OFF_WGU + 2 * SZ_WGU;
constexpr size_t OFF_WBA = OFF_WD + 2 * SZ_WD;
constexpr size_t OFF_RSTD = OFF_WBA + 2 * 8 * 1024 * 4;
constexpr size_t OFF_BETA = OFF_RSTD + (size_t)TT * 4;
constexpr size_t OFF_GLOG = OFF_BETA + (size_t)TT * 16;
constexpr size_t OFF_AL = OFF_GLOG + (size_t)TT * 16;
constexpr size_t OFF_BAR = OFF_AL + 16384;
constexpr size_t OFF_FLAG = OFF_BAR + 16384;
constexpr size_t OFF_SPARE = OFF_FLAG + 16384;
constexpr size_t OFF_XB = OFF_SPARE + (size_t)18 * 196608;
constexpr size_t OFF_PQKV = OFF_XB + (size_t)TT * 1024 * 2;
constexpr size_t OFF_PSC = OFF_PQKV + (size_t)TT * 1536 * 2;
constexpr size_t OFF_PZ = OFF_PSC + (size_t)TT * 1536 * 2;
constexpr size_t OFF_ACT = OFF_PQKV;
constexpr size_t OFF_FR = OFF_PZ + (size_t)TT * 512 * 2;
constexpr size_t FR_STRIDE = 74752, FR_W = 0, FR_KT = 16384, FR_QG = 32768, FR_QK = 49152, FR_U = 57344, FR_META = 73728;
constexpr size_t OFF_RAW = OFF_FR;
constexpr size_t WS_NEED = OFF_FR + (size_t)NCHH * FR_STRIDE;
static_assert((size_t)TT * 1024 * 4 <= (size_t)NCHH * FR_STRIDE, "raw fits");
static_assert(WS_NEED <= (size_t)536870912, "workspace");

constexpr size_t O_Y = 0;
constexpr size_t O_CONVP = (size_t)TT * 1024;
constexpr size_t O_STP = O_CONVP + 2 * 2 * 3 * 1536;
constexpr size_t O_SCP = O_STP + (size_t)2 * 2 * 4 * 16384;
constexpr size_t O_CONVS = O_SCP + 2 * 2 * 2 * 512;
constexpr size_t O_STS = O_CONVS + (size_t)2 * 16 * 3 * 1536;
constexpr size_t O_SCS = O_STS + (size_t)2 * 16 * 4 * 16384;

struct Params {
    const float *xp, *xs, *cache_conv, *state0, *cache_sc, *n_mix_pre, *w_in, *conv_w, *a_log, *dt_bias, *gdn_nw, *conv_sc_w, *w_o,
        *n_mix_post, *n_ffn_pre, *w_gate, *w_up, *w_down, *n_ffn_post;
    float* out;
    unsigned char* ws;
};

DI float bf2f(bf16_t v) { return __uint_as_float(((unsigned)v) << 16); }
DI unsigned pk_bf16(float lo, float hi) {
    f32x2 v = {lo, hi};
    bf16v2 r = __builtin_convertvector(v, bf16v2);
    return __builtin_bit_cast(unsigned, r);
}
DI bf16_t f2bf(float x) { return (bf16_t)(pk_bf16(x, 0.f) & 0xffffu); }
DI float silu_f(float x) { return x / (1.f + __expf(-x)); }
DI float wave_sum(float v) {
    v += __builtin_bit_cast(float, __builtin_amdgcn_update_dpp(0, __builtin_bit_cast(int, v), 0xB1, 0xf, 0xf, true));
    v += __builtin_bit_cast(float, __builtin_amdgcn_update_dpp(0, __builtin_bit_cast(int, v), 0x4E, 0xf, 0xf, true));
    v += __builtin_bit_cast(float, __builtin_amdgcn_update_dpp(0, __builtin_bit_cast(int, v), 0x141, 0xf, 0xf, true));
    v += __builtin_bit_cast(float, __builtin_amdgcn_update_dpp(0, __builtin_bit_cast(int, v), 0x140, 0xf, 0xf, true));
    v += __builtin_bit_cast(float, __builtin_amdgcn_update_dpp(0, __builtin_bit_cast(int, v), 0x142, 0xa, 0xf, false));
    v += __builtin_bit_cast(float, __builtin_amdgcn_update_dpp(0, __builtin_bit_cast(int, v), 0x143, 0xc, 0xf, false));
    return __builtin_bit_cast(float, __builtin_amdgcn_readlane(__builtin_bit_cast(int, v), 63));
}
DI bf16x8 pack8(const f32x4& a, const f32x4& b) {
    u32x4 p; p.x = pk_bf16(a[0], a[1]); p.y = pk_bf16(a[2], a[3]); p.z = pk_bf16(b[0], b[1]); p.w = pk_bf16(b[2], b[3]);
    return __builtin_bit_cast(bf16x8, p);
}

DI unsigned char* sv_home(const Params& p, int u) {
    const int c = u >> 2, h = u & 3;
    if (c < 512) {
        const int n = c & 255, b = c >> 8;
        if (n > 0) return ws_fresh(p.ws) + OFF_PQKV + (size_t)(b * 16384 + (n - 1) * 64) * 3072 + (size_t)h * 49152;
        return ws_fresh(p.ws) + OFF_SPARE + (size_t)b * 196608 + (size_t)h * 49152;
    }
    return ws_fresh(p.ws) + OFF_SPARE + (size_t)(2 + c - 512) * 196608 + (size_t)h * 49152;
}
DI void wait_count(unsigned* f, unsigned need) {
    unsigned sp = 0;
    while (__hip_atomic_load(f, __ATOMIC_RELAXED, __HIP_MEMORY_SCOPE_AGENT) < need) { __builtin_amdgcn_s_sleep(2); if (++sp > (1u << 22)) break; }
    __builtin_amdgcn_fence(__ATOMIC_ACQUIRE, "agent");
    asm volatile("s_waitcnt vmcnt(0)" ::: "memory");
}
DI void wait_counts8(unsigned* f, int first, int last_valid, int lane, unsigned need) {
    int idx = first + (lane & 7); if (idx > last_valid) idx = last_valid;
    unsigned sp = 0;
    for (;;) {
        const unsigned v = __hip_atomic_load(f + idx, __ATOMIC_RELAXED, __HIP_MEMORY_SCOPE_AGENT);
        if (__all(v >= need)) break;
        __builtin_amdgcn_s_sleep(2);
        if (++sp > (1u << 22)) break;
    }
    __builtin_amdgcn_fence(__ATOMIC_ACQUIRE, "agent");
    asm volatile("s_waitcnt vmcnt(0)" ::: "memory");
}
#define MFMA16(a, b, c) __builtin_amdgcn_mfma_f32_16x16x32_bf16((a), (b), (c), 0, 0, 0)

namespace pg8 {
constexpr int BM = 256, BK = 64, HALF = 128, HTB = HALF * BK * 2, STAGE_BYTES = 8 * HTB, NXCD = 8, WGM = 8;
DI int lds_byte(int r, int c) { const int st = (r >> 4) * 2 + (c >> 5), rr = r & 15, cc = c & 31, ob = rr * 64 + cc * 2; return st * 1024 + (ob ^ (((ob >> 9) & 1) << 5)); }
DI void stage_rc(int b, int& R, int& C) { const int st = b / 1024, sb = b % 1024, swz = sb ^ (((sb >> 9) & 1) << 5); R = (st >> 1) * 16 + swz / 64; C = (st & 1) * 32 + (swz % 64) / 2; }
DI int perm32(int rho) { const int n = rho >> 4, i = rho & 15; return 8 * (i >> 2) + 4 * n + (i & 3); }
struct Unit { int pm, pn, nt; unsigned kofs; };
struct Gemm { const bf16_t* A; const bf16_t* Bt; int M, N, K; };
struct StaticOrder {
    int nM, nN, nwg, G, c, ntf;
    DI void init(int M, int N, int K, int G_, int c_) { nM = M / BM; nN = N / BM; nwg = nM * nN; G = G_; c = c_; ntf = K / BK; }
    DI void map(int wgid, Unit& u) const {
        { const int q = nwg / NXCD, r = nwg % NXCD, xcd = wgid % NXCD, off = wgid / NXCD; wgid = (xcd < r ? xcd * (q + 1) : r * (q + 1) + (xcd - r) * q) + off; }
        const int nig = WGM * nN, gid = wgid / nig, fm = gid * WGM, gsz = (nM - fm) < WGM ? (nM - fm) : WGM;
        u.pm = fm + ((wgid % nig) % gsz); u.pn = (wgid % nig) / gsz; u.nt = ntf; u.kofs = 0u;
    }
    DI bool next(int i, Unit& u) const {
        const long L = (long)i * G + c; if (L >= nwg) return false;
        map((int)L, u); return true;
    }
};
struct SplitOrder : StaticOrder {
    int nsub;
    DI void init(int N, int K, int G_, int c_) { StaticOrder::init(TP, N, K, G_, c_); nsub = nN * (K / 256); }
    DI bool next(int i, Unit& u) const {
        const long L = (long)i * G + c;
        if (L < nwg) { map((int)L, u); return true; }
        const int j = (int)(L - nwg); if (j >= nsub) return false;
        u.pm = 128; u.pn = j % nN; u.nt = 4; u.kofs = (unsigned)(j / nN) * 512u; return true;
    }
};
template <class Epi, class Sched, bool ALIGN_EPI = true>
DI void gemm_phase(LAS unsigned char* lds, const Gemm g, const Sched& S, const Epi& E) {
    const int tid = tid_fresh(), wid = __builtin_amdgcn_readfirstlane(tid >> 6), lane = tid & 63, wr = wid >> 2, wc = wid & 3, fr = lane & 15, fq = lane >> 4;
    const int K = g.K;
    unsigned voffA[2], voffB[2];
#pragma unroll
    for (int i = 0; i < 2; ++i) { int R, C; stage_rc(tid * 16 + i * 8192, R, C); const int Rb = ((R & ~31) + perm32(R & 31));
        voffA[i] = (unsigned)(R * K + C) * 2u; voffB[i] = (unsigned)(Rb * K + C) * 2u; }
    const size_t kstep = (size_t)(BK * 2);
    const size_t hstep = (size_t)HALF * K * 2;
    const size_t tstep = 2 * hstep;
    const unsigned ldsw = (unsigned)wid * 1024u;
    const int aoff = lds_byte(wr * 64 + fr, fq * 8), boff = lds_byte(wc * 32 + fr, fq * 8);
#define PG8_SA(b, h) (((b) * 2 + (h)) * HTB)
#define PG8_SB(b, h) ((4 + (b) * 2 + (h)) * HTB)
#define PG8_STAGE(bufoff, gbase, voff) do { _Pragma("unroll") for (int _i = 0; _i < 2; ++_i) \
        __builtin_amdgcn_global_load_lds((const unsigned*)((const char*)(gbase) + (voff)[_i]), (LAS unsigned*)(lds + (bufoff) + ldsw + _i * 8192), 16, 0, 0); } while (0)
#define PG8_LDA(dst, b, h) do { _Pragma("unroll") for (int m = 0; m < 4; ++m) _Pragma("unroll") for (int k = 0; k < 2; ++k) dst[m][k] = *(const LAS bf16x8*)(lds + PG8_SA(b, h) + aoff + m * 2048 + k * 1024); } while (0)
#define PG8_LDB(dst, b, h) do { _Pragma("unroll") for (int n = 0; n < 2; ++n) _Pragma("unroll") for (int k = 0; k < 2; ++k) dst[n][k] = *(const LAS bf16x8*)(lds + PG8_SB(b, h) + boff + n * 2048 + k * 1024); } while (0)
#define PG8_MMA(ai, bj, At, Bt) do { __builtin_amdgcn_s_setprio(1); _Pragma("unroll") for (int m = 0; m < 4; ++m) _Pragma("unroll") for (int n = 0; n < 2; ++n) _Pragma("unroll") for (int k = 0; k < 2; ++k) \
        acc[ai][bj][m][n] = __builtin_amdgcn_mfma_f32_16x16x32_bf16(Bt[n][k], At[m][k], acc[ai][bj][m][n], 0, 0, 0); __builtin_amdgcn_s_setprio(0); } while (0)
#define PG8_WAIT_V(n) asm volatile("s_waitcnt vmcnt(" #n ")" ::: "memory")
#define PG8_WAIT_L(n) asm volatile("s_waitcnt lgkmcnt(" #n ")" ::: "memory")
#define PG8_BAR __builtin_amdgcn_s_barrier()
#define PG8_SCHED __builtin_amdgcn_sched_barrier(0)
    Unit cur, nxt; int ui = 0;
    if (!S.next(0, cur)) return;
    f32x4 acc[2][2][4][2];
#pragma unroll
    for (int a = 0; a < 2; ++a)
#pragma unroll
        for (int b = 0; b < 2; ++b)
#pragma unroll
            for (int m = 0; m < 4; ++m)
#pragma unroll
                for (int n = 0; n < 2; ++n) acc[a][b][m][n] = (f32x4){0.f, 0.f, 0.f, 0.f};
    bf16x8 At[4][2], B0[2][2], B1[2][2];
    const char* cA = (const char*)g.A + (size_t)cur.pm * tstep + cur.kofs; const char* cB = (const char*)g.Bt + (size_t)cur.pn * tstep + cur.kofs;
    PG8_STAGE(PG8_SB(0, 0), cB, voffB); PG8_STAGE(PG8_SB(0, 1), cB + hstep, voffB); PG8_STAGE(PG8_SA(0, 0), cA, voffA); PG8_STAGE(PG8_SA(0, 1), cA + hstep, voffA);
    if (wr == 1) PG8_BAR;
    PG8_WAIT_V(2); PG8_BAR;
    PG8_STAGE(PG8_SB(1, 0), cB + kstep, voffB); PG8_STAGE(PG8_SA(1, 0), cA + kstep, voffA); PG8_STAGE(PG8_SB(1, 1), cB + hstep + kstep, voffB);
    PG8_WAIT_V(6); PG8_BAR;
    for (;;) {
        const bool has_next = S.next(ui + 1, nxt);
        const char* nA = has_next ? (const char*)g.A + (size_t)nxt.pm * tstep + nxt.kofs : cA; const char* nB = has_next ? (const char*)g.Bt + (size_t)nxt.pn * tstep + nxt.kofs : cB;
        const int nt = cur.nt;
        for (int t = 0; t < nt; t += 2) {
            const bool last = (t == nt - 2);
            const char* a1 = cA + (size_t)(t + 1) * kstep;
            const char* a2 = last ? nA : cA + (size_t)(t + 2) * kstep; const char* b2 = last ? nB : cB + (size_t)(t + 2) * kstep;
            const char* a3 = a2 + kstep; const char* b3 = b2 + kstep;
            PG8_LDB(B0, 0, 0); PG8_LDB(B1, 0, 1); PG8_SCHED; PG8_LDA(At, 0, 0); PG8_STAGE(PG8_SA(1, 1), a1 + hstep, voffA);
            PG8_WAIT_V(8); PG8_WAIT_L(0); PG8_BAR; PG8_MMA(0, 0, At, B0); PG8_MMA(0, 1, At, B1); PG8_BAR; PG8_SCHED;
            PG8_LDA(At, 0, 1); PG8_STAGE(PG8_SB(0, 0), b2, voffB); PG8_STAGE(PG8_SB(0, 1), b2 + hstep, voffB); PG8_STAGE(PG8_SA(0, 0), a2, voffA);
            PG8_WAIT_V(8); PG8_WAIT_L(0); PG8_BAR; PG8_MMA(1, 0, At, B0); PG8_MMA(1, 1, At, B1); PG8_BAR; PG8_SCHED;
            PG8_LDB(B0, 1, 0); PG8_LDB(B1, 1, 1); PG8_SCHED; PG8_LDA(At, 1, 0); PG8_STAGE(PG8_SA(0, 1), a2 + hstep, voffA);
            PG8_WAIT_V(8); PG8_WAIT_L(0); PG8_BAR; PG8_MMA(0, 0, At, B0); PG8_MMA(0, 1, At, B1); PG8_BAR; PG8_SCHED;
            PG8_LDA(At, 1, 1); PG8_STAGE(PG8_SB(1, 0), b3, voffB); PG8_STAGE(PG8_SB(1, 1), b3 + hstep, voffB); PG8_STAGE(PG8_SA(1, 0), a3, voffA);
            PG8_WAIT_V(8); PG8_WAIT_L(0); PG8_BAR; PG8_MMA(1, 0, At, B0); PG8_MMA(1, 1, At, B1); PG8_BAR; PG8_SCHED;
        }
        if constexpr (ALIGN_EPI) { if (wr == 0) PG8_BAR; }
        E(acc, cur, wr, wc, fr, fq);
        if (!has_next) break;
#pragma unroll
        for (int a = 0; a < 2; ++a)
#pragma unroll
            for (int b = 0; b < 2; ++b)
#pragma unroll
                for (int m = 0; m < 4; ++m)
#pragma unroll
                    for (int n = 0; n < 2; ++n) acc[a][b][m][n] = (f32x4){0.f, 0.f, 0.f, 0.f};
        cur = nxt; cA = nA; cB = nB; ++ui;
        if constexpr (ALIGN_EPI) { if (wr == 1) PG8_BAR; }
    }
    PG8_WAIT_V(0);
    if constexpr (!ALIGN_EPI) { if (wr == 0) PG8_BAR; }
    PG8_BAR;
#undef PG8_SA
#undef PG8_SB
#undef PG8_STAGE
#undef PG8_LDA
#undef PG8_LDB
#undef PG8_MMA
#undef PG8_WAIT_V
#undef PG8_WAIT_L
#undef PG8_BAR
#undef PG8_SCHED
}
}

using pg8::Unit;
typedef f32x4 AccT[2][2][4][2];

struct EpiG1 {
    const float* rstd; bf16_t *pqkv, *psc, *pz;
    DI void operator()(const AccT& acc, const Unit& u, int wr, int wc, int fr, int fq) const {
        bf16_t* base; int ldc, colt;
        if (u.pn < 6) { base = pqkv; ldc = 1536; colt = u.pn * 256; }
        else if (u.pn < 8) { base = pz; ldc = 512; colt = (u.pn - 6) * 256; }
        else { base = psc; ldc = 1536; colt = (u.pn - 8) * 256; }
        const int row0 = u.pm * 256 + wr * 64 + fr, col0 = colt + wc * 32 + 8 * fq;
#pragma unroll
        for (int ai = 0; ai < 2; ++ai)
#pragma unroll
            for (int m = 0; m < 4; ++m) {
                const int row = row0 + ai * 128 + m * 16;
                bf16_t* rowp = base + (size_t)row * ldc + col0;
#pragma unroll
                for (int bj = 0; bj < 2; ++bj) {
                    const f32x4 v0 = acc[ai][bj][m][0], v1 = acc[ai][bj][m][1];
                    u32x4 w; w.x = pk_bf16(v0[0], v0[1]); w.y = pk_bf16(v0[2], v0[3]); w.z = pk_bf16(v1[0], v1[1]); w.w = pk_bf16(v1[2], v1[3]);
                    *(u32x4*)(rowp + bj * 128) = w;
                }
            }
    }
};
struct EpiRawSplit {
    bf16_t* C; float* racc;
    DI void operator()(const AccT& acc, const Unit& u, int wr, int wc, int fr, int fq) const {
        const int row0 = u.pm * 256 + wr * 64 + fr, col0 = u.pn * 256 + wc * 32 + 8 * fq;
        if (u.pm < 128) {
#pragma unroll
            for (int ai = 0; ai < 2; ++ai)
#pragma unroll
                for (int m = 0; m < 4; ++m) {
                    bf16_t* rowp = C + (size_t)(row0 + ai * 128 + m * 16) * 1024 + col0;
#pragma unroll
                    for (int bj = 0; bj < 2; ++bj) {
                        const f32x4 v0 = acc[ai][bj][m][0], v1 = acc[ai][bj][m][1];
                        u32x4 w; w.x = pk_bf16(v0[0], v0[1]); w.y = pk_bf16(v0[2], v0[3]); w.z = pk_bf16(v1[0], v1[1]); w.w = pk_bf16(v1[2], v1[3]);
                        *(u32x4*)(rowp + bj * 128) = w;
                    }
                }
        } else {
#pragma unroll
            for (int ai = 0; ai < 2; ++ai)
#pragma unroll
                for (int m = 0; m < 4; ++m) {
                    float* rowp = racc + (size_t)(u.kofs >> 9) * 262144 + (size_t)(row0 - TP + ai * 128 + m * 16) * 1024 + col0;
#pragma unroll
                    for (int bj = 0; bj < 2; ++bj) { *(f32x4*)(rowp + bj * 128) = acc[ai][bj][m][0]; *(f32x4*)(rowp + bj * 128 + 4) = acc[ai][bj][m][1]; }
                }
        }
    }
};
struct EpiGU {
    const float* rstd; bf16_t* act;
    DI void operator()(const AccT& acc, const Unit& u, int wr, int wc, int fr, int fq) const {
        const int row0 = u.pm * 256 + wr * 64 + fr, col0 = u.pn * 128 + wc * 32 + 8 * fq;
#pragma unroll
        for (int ai = 0; ai < 2; ++ai)
#pragma unroll
            for (int m = 0; m < 4; ++m) {
                const int row = row0 + ai * 128 + m * 16;
                float o[8];
#pragma unroll
                for (int n = 0; n < 2; ++n)
#pragma unroll
                    for (int i = 0; i < 4; ++i) { const float gv = acc[ai][0][m][n][i], uv = acc[ai][1][m][n][i]; o[n * 4 + i] = gv * __builtin_amdgcn_rcpf(1.f + __expf(-gv)) * uv; }
                u32x4 w; w.x = pk_bf16(o[0], o[1]); w.y = pk_bf16(o[2], o[3]); w.z = pk_bf16(o[4], o[5]); w.w = pk_bf16(o[6], o[7]);
                *(u32x4*)(act + (size_t)row * DFF + col0) = w;
            }
    }
};

DI void wtile(const float* src, int ld, int k0, int n0, const float* gain, bf16_t* dst, int K, int nd0, unsigned char* smem) {
    bf16_t* tl = (bf16_t*)smem;
    const int tid = tid_fresh();
    {
        const int kk = tid >> 2, cs = (tid & 3) * 16;
        const float gsc = gain ? gain[k0 + kk] : 1.f;
        const float* sp = src + (size_t)(k0 + kk) * ld + n0 + cs;
        f32x4 v[4];
#pragma unroll
        for (int q = 0; q < 4; ++q) v[q] = *(const f32x4*)(sp + 4 * q);
#pragma unroll
        for (int q = 0; q < 4; ++q)
#pragma unroll
            for (int i = 0; i < 4; ++i) tl[(cs + 4 * q + i) * 136 + kk] = f2bf(v[q][i] * gsc);
    }
    __syncthreads();
    {
        const int n = tid >> 3, ks = (tid & 7) * 16;
        const u32x4 v0 = *(const u32x4*)(tl + n * 136 + ks), v1 = *(const u32x4*)(tl + n * 136 + ks + 8);
        bf16_t* dp = dst + (size_t)(nd0 + n) * K + k0 + ks;
        *(u32x4*)dp = v0; *(u32x4*)(dp + 8) = v1;
    }
    __syncthreads();
}
DI void phase_weights(const Params& p, unsigned char* smem, int jb, int je, int cfirst) {
    constexpr int PER = 448 + 128 + 704 + 352;
    const int bid = bid_fresh();
    if (bid < cfirst) return;
    for (int j = jb + bid - cfirst; j < je; j += (int)gridDim.x - cfirst) {
        const int l = j / PER; int r = j % PER;
        if (r < 448) {
            const int kt = r / 56, nt = r % 56, nd0 = nt * 64, n0 = nd0 < 2048 ? nd0 : nd0 + 8;
            wtile(p.w_in + (size_t)l * 1024 * INDIM, INDIM, kt * 128, n0, p.n_mix_pre + l * 1024, (bf16_t*)(ws_fresh(p.ws) + OFF_WIN + l * SZ_WIN), 1024, nd0, smem);
        } else if (r < 448 + 128) {
            r -= 448; const int kt = r / 16, nt = r % 16;
            wtile(p.w_o + (size_t)l * 1024 * 1024, 1024, kt * 128, nt * 64, nullptr, (bf16_t*)(ws_fresh(p.ws) + OFF_WO + l * SZ_WO), 1024, nt * 64, smem);
        } else if (r < 448 + 128 + 704) {
            r -= 448 + 128; const int kt = r / 88, nt = r % 88, nd0 = nt * 64, pp = nd0 / 256, s = (nd0 % 256) / 128, jj = nd0 % 128;
            const float* src = (s ? p.w_up : p.w_gate) + (size_t)l * 1024 * DFF;
            wtile(src, DFF, kt * 128, pp * 128 + jj, p.n_ffn_pre + l * 1024, (bf16_t*)(ws_fresh(p.ws) + OFF_WGU + l * SZ_WGU), 1024, nd0, smem);
        } else {
            r -= 448 + 128 + 704; const int kt = r / 16, nt = r % 16;
            wtile(p.w_down + (size_t)l * DFF * 1024, 1024, kt * 128, nt * 64, nullptr, (bf16_t*)(ws_fresh(p.ws) + OFF_WD + l * SZ_WD), DFF, nt * 64, smem);
        }
    }
}

template <int MODE>
DI void row_phase(const Params& p, int layer, int lnext, unsigned char* smem) {
    const int tid = tid_fresh(), wid = tid >> 6, lane = tid & 63, bid = bid_fresh();
    float* wl = (float*)smem;
    if (MODE == 0 || MODE == 2) {
        for (int i = tid; i < 8192; i += 512) {
            const int k = i >> 3, j = i & 7;
            wl[j * 1024 + k] = p.n_mix_pre[lnext * 1024 + k] * p.w_in[((size_t)lnext * 1024 + k) * INDIM + 2048 + j];
        }
        __syncthreads();
    }
    const bf16_t* raw = (const bf16_t*)(ws_fresh(p.ws) + OFF_RAW);
    bf16_t* xa = (bf16_t*)(ws_fresh(p.ws) + OFF_XB);
    float* rstd = (float*)(ws_fresh(p.ws) + OFF_RSTD);
    const float* gain = MODE == 1 ? p.n_mix_post + layer * 1024 : p.n_ffn_post + layer * 1024;
    f32x4 gn[4];
    if (MODE != 0) {
#pragma unroll
        for (int hh = 0; hh < 2; ++hh) { gn[2 * hh] = *(const f32x4*)(gain + hh * 512 + lane * 8); gn[2 * hh + 1] = *(const f32x4*)(gain + hh * 512 + lane * 8 + 4); }
    }
    constexpr int NR = 2;
    const int gw = bid * 8 + wid, nw = gridDim.x * 8;
    for (int rb = gw * NR; rb < TT; rb += nw * NR) {
        f32x4 x[NR][4];
        u32x4 rw[NR][2];
#pragma unroll
        for (int q = 0; q < NR; ++q) {
            const int r = rb + q;
            if (MODE == 0) {
                const float* res = r < TP ? p.xp + (size_t)r * 1024 : p.xs + (size_t)(r - TP) * 1024;
#pragma unroll
                for (int hh = 0; hh < 2; ++hh) { x[q][2 * hh] = *(const f32x4*)(res + hh * 512 + lane * 8); x[q][2 * hh + 1] = *(const f32x4*)(res + hh * 512 + lane * 8 + 4); }
            } else {
#pragma unroll
                for (int hh = 0; hh < 2; ++hh) {
                    const u32x4 v = *(const u32x4*)(xa + (size_t)r * 1024 + hh * 512 + lane * 8);
                    const float inv = 1.f / rstd[r];
                    x[q][2 * hh] = (f32x4){__uint_as_float(v.x << 16), __uint_as_float(v.x & 0xffff0000u), __uint_as_float(v.y << 16), __uint_as_float(v.y & 0xffff0000u)} * inv;
                    x[q][2 * hh + 1] = (f32x4){__uint_as_float(v.z << 16), __uint_as_float(v.z & 0xffff0000u), __uint_as_float(v.w << 16), __uint_as_float(v.w & 0xffff0000u)} * inv;
                    rw[q][hh] = __builtin_nontemporal_load((const u32x4*)(raw + (size_t)r * 1024 + hh * 512 + lane * 8));
                }
            }
        }
#pragma unroll
        for (int q = 0; q < NR; ++q) {
            const int r = rb + q;
            if (MODE != 0) {
                f32x4 f[4];
                if (rb >= TP) {
                    const float* ra = (const float*)(ws_fresh(p.ws) + OFF_PZ) + (size_t)(r - TP) * 1024 + lane * 8;
#pragma unroll
                    for (int i = 0; i < 4; ++i) f[i] = (f32x4){0.f, 0.f, 0.f, 0.f};
                    constexpr int NKC = MODE == 1 ? 4 : 11;
#pragma unroll 4
                    for (int kc = 0; kc < NKC; ++kc) {
                        const float* rk = ra + (size_t)kc * 262144;
                        const f32x4 t0 = *(const f32x4*)rk, t1 = *(const f32x4*)(rk + 4), t2 = *(const f32x4*)(rk + 512), t3 = *(const f32x4*)(rk + 516);
                        f[0] += t0; f[1] += t1; f[2] += t2; f[3] += t3;
                    }
                } else {
#pragma unroll
                    for (int hh = 0; hh < 2; ++hh) {
                        const u32x4 v = rw[q][hh];
                        f[2 * hh] = (f32x4){__uint_as_float(v.x << 16), __uint_as_float(v.x & 0xffff0000u), __uint_as_float(v.y << 16), __uint_as_float(v.y & 0xffff0000u)};
                        f[2 * hh + 1] = (f32x4){__uint_as_float(v.z << 16), __uint_as_float(v.z & 0xffff0000u), __uint_as_float(v.w << 16), __uint_as_float(v.w & 0xffff0000u)};
                    }
                }
                float ss = 0.f;
#pragma unroll
                for (int i = 0; i < 4; ++i) ss += f[i][0] * f[i][0] + f[i][1] * f[i][1] + f[i][2] * f[i][2] + f[i][3] * f[i][3];
                ss = wave_sum(ss);
                const float rs = rsqrtf(ss * (1.f / 1024.f) + 1e-6f);
#pragma unroll
                for (int i = 0; i < 4; ++i) x[q][i] += f[i] * rs * gn[i];
            }
            if (MODE == 3) {
                float* yo = p.out + O_Y + (size_t)r * 1024;
#pragma unroll
                for (int hh = 0; hh < 2; ++hh) { __builtin_nontemporal_store(x[q][2 * hh], (f32x4*)(yo + hh * 512 + lane * 8)); __builtin_nontemporal_store(x[q][2 * hh + 1], (f32x4*)(yo + hh * 512 + lane * 8 + 4)); }
            } else {
                float ss = 0.f;
#pragma unroll
                for (int i = 0; i < 4; ++i) ss += x[q][i][0] * x[q][i][0] + x[q][i][1] * x[q][i][1] + x[q][i][2] * x[q][i][2] + x[q][i][3] * x[q][i][3];
                ss = wave_sum(ss);
                const float rs = rsqrtf(ss * (1.f / 1024.f) + 1e-6f);
                if (lane == 0) rstd[r] = rs;
#pragma unroll
                for (int hh = 0; hh < 2; ++hh) {
                    const f32x4 n0 = x[q][2 * hh] * rs, n1 = x[q][2 * hh + 1] * rs;
                    u32x4 w; w.x = pk_bf16(n0[0], n0[1]); w.y = pk_bf16(n0[2], n0[3]); w.z = pk_bf16(n1[0], n1[1]); w.w = pk_bf16(n1[2], n1[3]);
                    *(u32x4*)(xa + (size_t)r * 1024 + hh * 512 + lane * 8) = w;
                }
                if (MODE == 0 || MODE == 2) {
                    float d[8];
#pragma unroll
                    for (int j = 0; j < 8; ++j) {
                        float a = 0.f;
#pragma unroll
                        for (int i = 0; i < 4; ++i) { const f32x4 w = *(const f32x4*)(wl + j * 1024 + (i >> 1) * 512 + lane * 8 + (i & 1) * 4); a += x[q][i][0] * w[0] + x[q][i][1] * w[1] + x[q][i][2] * w[2] + x[q][i][3] * w[3]; }
                        d[j] = wave_sum(a) * rs;
                    }
                    if (lane < 4) {
                        const float braw = lane == 0 ? d[0] : lane == 1 ? d[1] : lane == 2 ? d[2] : d[3];
                        const float araw = lane == 0 ? d[4] : lane == 1 ? d[5] : lane == 2 ? d[6] : d[7];
                        const float beta = 1.f / (1.f + __expf(-braw));
                        const float xv = araw + p.dt_bias[lnext * 4 + lane];
                        const float sp = xv > 20.f ? xv : log1pf(__expf(xv));
                        const float g = -__expf(p.a_log[lnext * 4 + lane]) * sp;
                        ((float*)(ws_fresh(p.ws) + OFF_BETA))[r * 4 + lane] = beta;
                        ((float*)(ws_fresh(p.ws) + OFF_GLOG))[r * 4 + lane] = g;
                    }
                }
            }
        }
    }
}

constexpr int KNS = 136;
constexpr int TBS = 72;
constexpr int C_QN = 0;
constexpr int C_KN = C_QN + 17408;
constexpr int C_VBT = C_KN + 17408;
constexpr int C_KBT = C_VBT + 18432;
constexpr int C_SM = C_KBT + 18432;
constexpr int C_AM = C_SM + 2048;
constexpr int C_TF = C_AM + 16384;
constexpr int C_TB = C_TF + 16384;
constexpr int C_QKL = C_TB + 9216;
constexpr int C_WL = C_QKL + 9216;
static_assert(C_WL + 17408 <= LDS_BYTES - 16, "lds");
DI f32x4 bflo4(const u32x4& v) { return (f32x4){__uint_as_float(v.x << 16), __uint_as_float(v.x & 0xffff0000u), __uint_as_float(v.y << 16), __uint_as_float(v.y & 0xffff0000u)}; }
DI f32x4 bfhi4(const u32x4& v) { return (f32x4){__uint_as_float(v.z << 16), __uint_as_float(v.z & 0xffff0000u), __uint_as_float(v.w << 16), __uint_as_float(v.w & 0xffff0000u)}; }
DI float row16_sum(float v) {
    v += __builtin_bit_cast(float, __builtin_amdgcn_update_dpp(0, __builtin_bit_cast(int, v), 0xB1, 0xf, 0xf, true));
    v += __builtin_bit_cast(float, __builtin_amdgcn_update_dpp(0, __builtin_bit_cast(int, v), 0x4E, 0xf, 0xf, true));
    v += __builtin_bit_cast(float, __builtin_amdgcn_update_dpp(0, __builtin_bit_cast(int, v), 0x141, 0xf, 0xf, true));
    v += __builtin_bit_cast(float, __builtin_amdgcn_update_dpp(0, __builtin_bit_cast(int, v), 0x140, 0xf, 0xf, true));
    return v;
}
DI float silu_fast(float x) { return x * __builtin_amdgcn_rcpf(1.f + __expf(-x)); }

DI void write_frags_rowmajor(const bf16_t* X, int ldx, int KS, int nfr, const float* rowscale, __amdgpu_buffer_rsrc_t rs, unsigned dofs, int t0, int nthr) {
    for (int it = t0; it < nfr * 64; it += nthr) {
        const int f = it >> 6, l = it & 63, mt = f / KS, ks = f % KS, m = mt * 16 + (l & 15), g = l >> 4;
        const bf16_t* rp = X + m * ldx + ks * 32 + 4 * g;
        const u32x2 lo = *(const u32x2*)rp, hi = *(const u32x2*)(rp + 16);
        u32x4 o;
        if (rowscale) {
            const float s = rowscale[m];
            o.x = pk_bf16(__uint_as_float(lo.x << 16) * s, __uint_as_float(lo.x & 0xffff0000u) * s);
            o.y = pk_bf16(__uint_as_float(lo.y << 16) * s, __uint_as_float(lo.y & 0xffff0000u) * s);
            o.z = pk_bf16(__uint_as_float(hi.x << 16) * s, __uint_as_float(hi.x & 0xffff0000u) * s);
            o.w = pk_bf16(__uint_as_float(hi.y << 16) * s, __uint_as_float(hi.y & 0xffff0000u) * s);
        } else { o.x = lo.x; o.y = lo.y; o.z = hi.x; o.w = hi.y; }
        __builtin_amdgcn_raw_buffer_store_b128(o, rs, dofs + (unsigned)it * 16u, 0, 16);
    }
}

DI void phase_chunk(const Params& p, int layer, unsigned char* smem, int first_block, int nblk) {
    const int tid = tid_fresh(), wid = tid >> 6, lane = tid & 63, bid = bid_fresh();
    bf16_t* QN = (bf16_t*)(smem + C_QN);
    bf16_t* KN = (bf16_t*)(smem + C_KN);
    bf16_t* VBT = (bf16_t*)(smem + C_VBT);
    bf16_t* KBT = (bf16_t*)(smem + C_KBT);
    bf16_t* QKL = (bf16_t*)(smem + C_QKL);
    bf16_t* TB = (bf16_t*)(smem + C_TB);
    float* SM = (float*)(smem + C_SM);
    float *GC = SM, *BETA = SM + 64, *EG = SM + 128, *EGL = SM + 192, *QS = SM + 256, *KS_ = SM + 320, *BE = SM + 384;
    float* AM = (float*)(smem + C_AM);
    float* TF = (float*)(smem + C_TF);
    bf16_t* WL = (bf16_t*)(smem + C_WL);
    const bf16_t* pqkv = (const bf16_t*)(ws_fresh(p.ws) + OFF_PQKV);
    const bf16_t* psc = (const bf16_t*)(ws_fresh(p.ws) + OFF_PSC);
    bf16_t* mixin = (bf16_t*)(p.out + O_Y);
    const float* betaA = (const float*)(ws_fresh(p.ws) + OFF_BETA);
    const float* glogA = (const float*)(ws_fresh(p.ws) + OFF_GLOG);

    unsigned* readyc = (unsigned*)(ws_fresh(p.ws) + OFF_FLAG) + layer * 528;
    int pending_c = -1;
    for (int o = bid - first_block; o < NCHH; o += nblk) {
        const int u = o < 2048 ? ((((o >> 2) & 1) * 256 + (o >> 3)) * 4 + (o & 3)) : o;
        const int c = u >> 2, h = u & 3;
        int row0, nvalid, sb = 0; bool first, lastc, prompt = c < 512;
        if (prompt) { const int b = c >> 8, n = c & 255; row0 = b * 16384 + n * 64; nvalid = 64; first = n == 0; lastc = n == 255; sb = b; }
        else { sb = c - 512; row0 = TP + sb * 16; nvalid = 16; first = true; lastc = true; }
        unsigned char* frb = ws_fresh(p.ws) + OFF_FR + (size_t)u * FR_STRIDE;
        const __amdgpu_buffer_rsrc_t frr = __builtin_amdgcn_make_buffer_rsrc(frb, 0, (int)FR_STRIDE, 0x00020000);

        const int rg = tid / 48, cg = tid % 48, which = cg >> 4, c0 = (cg & 15) * 8, col0 = which * 512 + h * 128 + c0, r0 = rg * 8;
        u32x4 raw[11];
        const bool use_cache = (tid < 384) && rg == 0 && first && !prompt;
        if (tid < 384) {
#pragma unroll
            for (int i = 0; i < 11; ++i) {
                int rr = r0 - 3 + i;
                if (rr >= nvalid) rr = 0;
                if (rr < 0 && first) rr = 0;
                raw[i] = *(const u32x4*)(pqkv + (size_t)(row0 + rr) * 1536 + col0);
            }
        }
        if (wid == 7) {
            const int r = lane;
            float gv = 0.f, bv = 0.f;
            if (r < nvalid) { gv = glogA[(size_t)(row0 + r) * 4 + h]; bv = betaA[(size_t)(row0 + r) * 4 + h]; }
            float cs = gv;
#pragma unroll
            for (int o = 1; o < 64; o <<= 1) { const float t = __shfl_up(cs, o); if (lane >= o) cs += t; }
            const float gl = __shfl(cs, 63);
            const float egv = __expf(cs); GC[r] = cs; BETA[r] = bv; EG[r] = egv; BE[r] = bv * egv; EGL[r] = __expf(gl - cs);
            const float alx = __expf(gl);
            if (r == 0) __hip_atomic_store((float*)(ws_fresh(p.ws) + OFF_AL) + u, alx, __ATOMIC_RELAXED, __HIP_MEMORY_SCOPE_AGENT);
            { const unsigned ab = __float_as_uint(alx); __builtin_amdgcn_raw_buffer_store_b128((u32x4){ab, ab, ab, ab}, frr, (unsigned)(FR_META + lane * 16), 0, 16); }
        }
        asm volatile("s_waitcnt vmcnt(0)" ::: "memory");
        __syncthreads();
        if (pending_c >= 0 && tid == 0) __hip_atomic_fetch_add(readyc + pending_c, 1u, __ATOMIC_RELAXED, __HIP_MEMORY_SCOPE_AGENT);
        if (tid < 384) {
            const float* cw = p.conv_w + layer * 4 * 1536 + col0;
            f32x4 wv[4][2];
#pragma unroll
            for (int i = 0; i < 4; ++i) { wv[i][0] = *(const f32x4*)(cw + i * 1536); wv[i][1] = *(const f32x4*)(cw + i * 1536 + 4); }
            f32x4 xin[11][2];
#pragma unroll
            for (int i = 0; i < 11; ++i) {
                xin[i][0] = bflo4(raw[i]); xin[i][1] = bfhi4(raw[i]);
                if (i < 3 && rg == 0 && first) {
                    if (use_cache) {
                        const float* cp = p.cache_conv + ((size_t)(layer * 16 + sb) * 3 + i) * 1536 + col0;
                        xin[i][0] = *(const f32x4*)cp; xin[i][1] = *(const f32x4*)(cp + 4);
                    } else { xin[i][0] = (f32x4){0.f, 0.f, 0.f, 0.f}; xin[i][1] = xin[i][0]; }
                }
            }
            if (lastc && r0 + 8 == ((nvalid + 7) & ~7) ) {
                float* co = prompt ? p.out + O_CONVP + ((size_t)(layer * 2 + sb) * 3) * 1536 + col0 : p.out + O_CONVS + ((size_t)(layer * 16 + sb) * 3) * 1536 + col0;
                const int jl = nvalid - 1 - r0;
#pragma unroll
                for (int i = 0; i < 3; ++i) { *(f32x4*)(co + i * 1536) = xin[jl + 1 + i][0]; *(f32x4*)(co + i * 1536 + 4) = xin[jl + 1 + i][1]; }
            }
            float yv[8][8];
#pragma unroll
            for (int j = 0; j < 8; ++j) {
                const bool valid = r0 + j < nvalid;
                const f32x4 a0 = wv[0][0] * xin[j][0] + wv[1][0] * xin[j + 1][0] + wv[2][0] * xin[j + 2][0] + wv[3][0] * xin[j + 3][0];
                const f32x4 a1 = wv[0][1] * xin[j][1] + wv[1][1] * xin[j + 1][1] + wv[2][1] * xin[j + 2][1] + wv[3][1] * xin[j + 3][1];
#pragma unroll
                for (int e = 0; e < 4; ++e) { yv[j][e] = valid ? silu_fast(a0[e]) : 0.f; yv[j][4 + e] = valid ? silu_fast(a1[e]) : 0.f; }
            }
            if (which < 2) {
                bf16_t* dstn = (which ? KN : QN);
#pragma unroll
                for (int j = 0; j < 8; ++j) {
                    float ss = 0.f;
#pragma unroll
                    for (int e = 0; e < 8; ++e) ss += yv[j][e] * yv[j][e];
                    ss = row16_sum(ss);
                    const float sc = rsqrtf(ss + 1e-6f) * (which ? 1.f : 0.08838834764831845f);
#pragma unroll
                    for (int e = 0; e < 8; ++e) yv[j][e] *= sc;
                    u32x4 w; w.x = pk_bf16(yv[j][0], yv[j][1]); w.y = pk_bf16(yv[j][2], yv[j][3]); w.z = pk_bf16(yv[j][4], yv[j][5]); w.w = pk_bf16(yv[j][6], yv[j][7]);
                    *(u32x4*)(dstn + (r0 + j) * KNS + c0) = w;
                }
            }
            if (which >= 1) {
                bf16_t* dstt = (which == 1 ? KBT : VBT);
                const float* scl = (which == 1 ? BE : BETA);
                float sc8[8];
#pragma unroll
                for (int j = 0; j < 8; ++j) sc8[j] = scl[r0 + j];
#pragma unroll
                for (int e = 0; e < 8; ++e) {
                    u32x4 w; w.x = pk_bf16(yv[0][e] * sc8[0], yv[1][e] * sc8[1]); w.y = pk_bf16(yv[2][e] * sc8[2], yv[3][e] * sc8[3]);
                    w.z = pk_bf16(yv[4][e] * sc8[4], yv[5][e] * sc8[5]); w.w = pk_bf16(yv[6][e] * sc8[6], yv[7][e] * sc8[7]);
                    *(u32x4*)(dstt + (c0 + e) * TBS + r0) = w;
                }
            }
        } else {
#pragma unroll 1
            for (int kb = 0; kb < 2; ++kb) {
                u32x4 scv[2][4], shv[2][4], sbv[2][2];
#pragma unroll
                for (int k2 = 0; k2 < 2; ++k2) {
                    const int it = (tid - 384) + 128 * (kb * 2 + k2), sr0 = (it >> 4) * 2, ch0 = h * 128 + (it & 15) * 8;
#pragma unroll
                    for (int i = 0; i < 4; ++i) {
                        int rr = sr0 - 2 + i;
                        if (rr >= nvalid) rr = 0;
                        if (rr < 0 && first) rr = 0;
                        const bf16_t* rp = psc + (size_t)(row0 + rr) * 1536 + ch0;
                        scv[k2][i] = *(const u32x4*)(rp + 512); shv[k2][i] = *(const u32x4*)(rp + 1024);
                        if (i >= 2) sbv[k2][i - 2] = *(const u32x4*)rp;
                    }
                }
#pragma unroll
                for (int k2 = 0; k2 < 2; ++k2) {
                    const int it = (tid - 384) + 128 * (kb * 2 + k2), sr0 = (it >> 4) * 2, ch0 = h * 128 + (it & 15) * 8;
                    if (sr0 < nvalid) {
                        const float* cw = p.conv_sc_w + layer * 3 * 512 + ch0;
                        f32x4 wv[3][2];
#pragma unroll
                        for (int i = 0; i < 3; ++i) { wv[i][0] = *(const f32x4*)(cw + i * 512); wv[i][1] = *(const f32x4*)(cw + i * 512 + 4); }
                        f32x4 pr[4][2];
#pragma unroll
                        for (int i = 0; i < 4; ++i) {
                            const int rr = sr0 - 2 + i;
                            if (rr < 0 && first) {
                                if (prompt) { pr[i][0] = (f32x4){0.f, 0.f, 0.f, 0.f}; pr[i][1] = pr[i][0]; }
                                else { const float* cp = p.cache_sc + ((size_t)(layer * 16 + sb) * 2 + (rr + 2)) * 512 + ch0; pr[i][0] = *(const f32x4*)cp; pr[i][1] = *(const f32x4*)(cp + 4); }
                            } else { pr[i][0] = bflo4(scv[k2][i]) * bflo4(shv[k2][i]); pr[i][1] = bfhi4(scv[k2][i]) * bfhi4(shv[k2][i]); }
                        }
#pragma unroll
                        for (int j = 0; j < 2; ++j) {
                            const u32x4 bvv = sbv[k2][j];
                            const f32x4 y0 = bflo4(bvv) * (wv[0][0] * pr[j][0] + wv[1][0] * pr[j + 1][0] + wv[2][0] * pr[j + 2][0]);
                            const f32x4 y1 = bfhi4(bvv) * (wv[0][1] * pr[j][1] + wv[1][1] * pr[j + 1][1] + wv[2][1] * pr[j + 2][1]);
                            u32x4 w; w.x = pk_bf16(y0[0], y0[1]); w.y = pk_bf16(y0[2], y0[3]); w.z = pk_bf16(y1[0], y1[1]); w.w = pk_bf16(y1[2], y1[3]);
                            *(u32x4*)(mixin + (size_t)(row0 + sr0 + j) * 1024 + 512 + ch0) = w;
                        }
                        if (lastc && sr0 == nvalid - 2) {
                            float* co = prompt ? p.out + O_SCP + ((size_t)(layer * 2 + sb) * 2) * 512 + ch0 : p.out + O_SCS + ((size_t)(layer * 16 + sb) * 2) * 512 + ch0;
                            *(f32x4*)co = pr[2][0]; *(f32x4*)(co + 4) = pr[2][1]; *(f32x4*)(co + 512) = pr[3][0]; *(f32x4*)(co + 516) = pr[3][1];
                        }
                    }
                }
            }
        }
        __syncthreads();
        const int tidb = tid_fresh(), widb = tidb >> 6, laneb = tidb & 63;
        for (int job = widb; job < 32; job += 8) {
            const int isqk = job >> 4, mi = (job >> 2) & 3, nj = job & 3;
            const int g = laneb >> 4, n = laneb & 15;
            if (mi < nj) {
#pragma unroll
                for (int e = 0; e < 4; ++e) { bf16_t* dst = (isqk ? QKL : TB) + (mi * 16 + 4 * g + e) * TBS + nj * 16 + n; *dst = 0; }
                continue;
            }
            const bf16_t* Arow = (isqk ? QN : KN) + (mi * 16 + n) * KNS + g * 8;
            const bf16_t* Brow = KN + (nj * 16 + n) * KNS + g * 8;
            f32x4 acc = {0.f, 0.f, 0.f, 0.f};
#pragma unroll
            for (int ks = 0; ks < 4; ++ks) {
                const bf16x8 a = *(const bf16x8*)(Arow + ks * 32), b = *(const bf16x8*)(Brow + ks * 32);
                acc = MFMA16(a, b, acc);
            }
            const int j = nj * 16 + n; const float gj = GC[j];
            if (isqk) {
#pragma unroll
                for (int e = 0; e < 4; ++e) {
                    const int i = mi * 16 + 4 * g + e;
                    const float v = (i >= j) ? acc[e] * __expf(GC[i] - gj) : 0.f; QKL[i * TBS + j] = f2bf(v);
                }
            } else {
                f32x4 v;
#pragma unroll
                for (int e = 0; e < 4; ++e) { const int i = mi * 16 + 4 * g + e; v[e] = (i > j) ? acc[e] * BETA[i] * __expf(GC[i] - gj) : 0.f; }
                *(f32x4*)(AM + j * 64 + mi * 16 + 4 * g) = v;
            }
        }
        __syncthreads();
        if (widb == 0) {
            const int b = laneb >> 4, cx = laneb & 15;
            const float* Ab = AM + (16 * b) * 64 + 16 * b;
            float x[16];
#pragma unroll
            for (int i = 0; i < 16; ++i) {
                float a = (i == cx) ? 1.f : 0.f;
#pragma unroll
                for (int j = 0; j < i; ++j) a -= Ab[j * 64 + i] * x[j];
                x[i] = a;
            }
#pragma unroll
            for (int i = 0; i < 16; ++i) { TF[(16 * b + i) * 64 + 16 * b + cx] = x[i]; TB[(16 * b + i) * TBS + 16 * b + cx] = f2bf(x[i]); }
        } else if (widb >= 4) {
            const int t0 = tidb - 256;
            write_frags_rowmajor(QN, KNS, 4, 16, EG, frr, (unsigned)FR_QG, t0, 256);
            write_frags_rowmajor(QKL, TBS, 2, 8, nullptr, frr, (unsigned)FR_QK, t0, 256);
            for (int it = t0; it < 16 * 64; it += 256) {
                const int f = it >> 6, l = it & 63, mt = f >> 1, ks = f & 1, m = mt * 16 + (l & 15), g = l >> 4;
                float v[8];
#pragma unroll
                for (int e = 0; e < 8; ++e) { const int j = ks * 32 + 16 * (e >> 2) + 4 * g + (e & 3); v[e] = bf2f(KN[j * KNS + m]) * EGL[j]; }
                u32x4 o; o.x = pk_bf16(v[0], v[1]); o.y = pk_bf16(v[2], v[3]); o.z = pk_bf16(v[4], v[5]); o.w = pk_bf16(v[6], v[7]);
                __builtin_amdgcn_raw_buffer_store_b128(o, frr, (unsigned)(FR_KT + it * 16), 0, 16);
            }
        }
        __syncthreads();
#pragma unroll
        for (int d = 1; d < 4; ++d) {
            if (widb < 4 - d) {
                const int b = widb, bi = b + d, g = laneb >> 4, n = laneb & 15;
                f32x4 acc = {0.f, 0.f, 0.f, 0.f};
                for (int k = b; k < bi; ++k) {
#pragma unroll
                    for (int ks = 0; ks < 4; ++ks) {
                        const float av = AM[(16 * k + 4 * ks + g) * 64 + 16 * bi + n];
                        const float bv = TF[(16 * k + 4 * ks + g) * 64 + 16 * b + n];
                        acc = __builtin_amdgcn_mfma_f32_16x16x4f32(av, bv, acc, 0, 0, 0);
                    }
                }
                f32x4 res = {0.f, 0.f, 0.f, 0.f};
#pragma unroll
                for (int e = 0; e < 4; ++e) {
                    const float dv = TF[(16 * bi + n) * 64 + 16 * bi + 4 * g + e];
                    res = __builtin_amdgcn_mfma_f32_16x16x4f32(dv, acc[e], res, 0, 0, 0);
                }
#pragma unroll
                for (int e = 0; e < 4; ++e) { const int i = 16 * bi + 4 * g + e; TF[i * 64 + 16 * b + n] = -res[e]; TB[i * TBS + 16 * b + n] = f2bf(-res[e]); }
            }
            __syncthreads();
        }
        {
            const int g = laneb >> 4, n = laneb & 15;
            bf16x8 ta[4][2];
#pragma unroll
            for (int mt = 0; mt < 4; ++mt)
#pragma unroll
                for (int ks = 0; ks < 2; ++ks) ta[mt][ks] = *(const bf16x8*)(TB + (mt * 16 + n) * TBS + ks * 32 + g * 8);
            f32x4 uo[4], wo[4];
#pragma unroll
            for (int mt = 0; mt < 4; ++mt) { uo[mt] = (f32x4){0.f, 0.f, 0.f, 0.f}; wo[mt] = (f32x4){0.f, 0.f, 0.f, 0.f}; }
#pragma unroll
            for (int ks = 0; ks < 2; ++ks) {
                const bf16x8 bu = *(const bf16x8*)(VBT + (widb * 16 + n) * TBS + ks * 32 + g * 8);
                const bf16x8 bw = *(const bf16x8*)(KBT + (widb * 16 + n) * TBS + ks * 32 + g * 8);
#pragma unroll
                for (int mt = 0; mt < 4; ++mt) { uo[mt] = MFMA16(ta[mt][ks], bu, uo[mt]); wo[mt] = MFMA16(ta[mt][ks], bw, wo[mt]); }
            }
            u32x4 a, b2;
            a.x = pk_bf16(uo[0][0], uo[0][1]); a.y = pk_bf16(uo[0][2], uo[0][3]); a.z = pk_bf16(uo[1][0], uo[1][1]); a.w = pk_bf16(uo[1][2], uo[1][3]);
            b2.x = pk_bf16(uo[2][0], uo[2][1]); b2.y = pk_bf16(uo[2][2], uo[2][3]); b2.z = pk_bf16(uo[3][0], uo[3][1]); b2.w = pk_bf16(uo[3][2], uo[3][3]);
            const unsigned uofs = (unsigned)(FR_U + (widb * 64 + laneb) * 32);
            __builtin_amdgcn_raw_buffer_store_b128(a, frr, uofs, 0, 16); __builtin_amdgcn_raw_buffer_store_b128(b2, frr, uofs + 16u, 0, 16);
#pragma unroll
            for (int mt = 0; mt < 4; ++mt)
#pragma unroll
                for (int e = 0; e < 4; ++e) WL[(mt * 16 + 4 * g + e) * KNS + widb * 16 + n] = f2bf(wo[mt][e]);
        }
        __syncthreads();
        write_frags_rowmajor(WL, KNS, 4, 16, nullptr, frr, (unsigned)FR_W, tidb, 512);
        pending_c = c;
    }
    asm volatile("s_waitcnt vmcnt(0)" ::: "memory");
    __syncthreads();
    if (pending_c >= 0 && tid == 0) __hip_atomic_fetch_add(readyc + pending_c, 1u, __ATOMIC_RELAXED, __HIP_MEMORY_SCOPE_AGENT);
}

DI void scan_task(const Params& p, int layer, int u0, int nsteps, const float* s0, float* sout, int s, int lane) {
    const int g = lane >> 4, n = lane & 15;
    f32x4 S[8];
#pragma unroll
    for (int mt = 0; mt < 8; ++mt)
#pragma unroll
        for (int e = 0; e < 4; ++e) S[mt][e] = s0 ? s0[(size_t)(mt * 16 + 4 * g + e) * 128 + s * 16 + n] : 0.f;
    const float* alA = (const float*)(ws_fresh(p.ws) + OFF_AL);
    for (int st = 0; st < nsteps; ++st) {
        const int u = u0 + st * 4;
        const unsigned char* frb = ws_fresh(p.ws) + OFF_FR + (size_t)u * FR_STRIDE;
        const u32x4* wf = (const u32x4*)(frb + FR_W) + lane;
        const u32x4* kf = (const u32x4*)(frb + FR_KT) + lane;
        const u32x4* uf = (const u32x4*)(frb + FR_U + (size_t)(s * 64 + lane) * 32);
        bf16x8 Sb[4];
#pragma unroll
        for (int ks = 0; ks < 4; ++ks) Sb[ks] = pack8(S[2 * ks], S[2 * ks + 1]);
        u32x4* sfr = (u32x4*)(sv_home(p, u) + (size_t)s * 4096) + lane;
#pragma unroll
        for (int ks = 0; ks < 4; ++ks) sfr[ks * 64] = __builtin_bit_cast(u32x4, Sb[ks]);
        const u32x4 u0v = uf[0], u1v = uf[1];
        f32x4 vn[4];
#pragma unroll
        for (int mt = 0; mt < 4; ++mt) {
            f32x4 acc = {0.f, 0.f, 0.f, 0.f};
#pragma unroll
            for (int ks = 0; ks < 4; ++ks) acc = MFMA16(__builtin_bit_cast(bf16x8, wf[(mt * 4 + ks) * 64]), Sb[ks], acc);
            const unsigned lo = mt == 0 ? u0v.x : mt == 1 ? u0v.z : mt == 2 ? u1v.x : u1v.z;
            const unsigned hi = mt == 0 ? u0v.y : mt == 1 ? u0v.w : mt == 2 ? u1v.y : u1v.w;
            vn[mt][0] = __uint_as_float(lo << 16) - acc[0]; vn[mt][1] = __uint_as_float(lo & 0xffff0000u) - acc[1];
            vn[mt][2] = __uint_as_float(hi << 16) - acc[2]; vn[mt][3] = __uint_as_float(hi & 0xffff0000u) - acc[3];
        }
        bf16x8 Vb[2];
        Vb[0] = pack8(vn[0], vn[1]); Vb[1] = pack8(vn[2], vn[3]);
        u32x4* vfr = (u32x4*)(sv_home(p, u) + 32768 + (size_t)s * 2048) + lane;
        vfr[0] = __builtin_bit_cast(u32x4, Vb[0]); vfr[64] = __builtin_bit_cast(u32x4, Vb[1]);
        const float al = alA[u];
#pragma unroll
        for (int mt = 0; mt < 8; ++mt) {
            S[mt] *= al;
#pragma unroll
            for (int ks = 0; ks < 2; ++ks) S[mt] = MFMA16(__builtin_bit_cast(bf16x8, kf[(mt * 2 + ks) * 64]), Vb[ks], S[mt]);
        }
    }
#pragma unroll
    for (int mt = 0; mt < 8; ++mt)
#pragma unroll
        for (int e = 0; e < 4; ++e) sout[(size_t)(mt * 16 + 4 * g + e) * 128 + s * 16 + n] = S[mt][e];
}
constexpr int SC_SLOT = 35840, SC_D = 3;
DI void scan_prompt(const Params& p, int layer, LAS unsigned char* lds, int tid, int b) {
    const int wid = __builtin_amdgcn_readfirstlane(tid >> 6), lane = tid & 63, g = lane >> 4, n = lane & 15;
    const int xcd = b & 7, s = b >> 3, bb = xcd >> 2, h = xcd & 3;
    const int u0 = (bb * 256) * 4 + h;
    const unsigned char* fr0 = ws_fresh(p.ws) + OFF_FR + (size_t)u0 * FR_STRIDE;
    const size_t stepB = 4 * FR_STRIDE;
    unsigned* readyc = (unsigned*)(ws_fresh(p.ws) + OFF_FLAG) + layer * 528 + bb * 256;
#define SC_ISSUE(st, slot) do { const unsigned char* _f = fr0 + (size_t)(st) * stepB; \
        _Pragma("unroll") for (int _i = 0; _i < 6; ++_i) { const int _q = (wid - 2) * 6 + _i; if (_q < 35) { \
            const unsigned char* _src = _q < 32 ? _f + _q * 1024 + lane * 16 : _q < 34 ? _f + FR_U + (size_t)(s * 64 + lane) * 32 + (_q - 32) * 16 : _f + FR_META + lane * 16; \
            __builtin_amdgcn_global_load_lds((const unsigned*)_src, (LAS unsigned*)(lds + (slot) * SC_SLOT + _q * 1024), 16, 0, 0); } } } while (0)
    f32x4 S[8];
#pragma unroll
    for (int mt = 0; mt < 8; ++mt) S[mt] = (f32x4){0.f, 0.f, 0.f, 0.f};
    if (wid == 1) { wait_counts8(readyc, 0, 255, lane, 4u); wait_counts8(readyc, 3, 255, lane, 4u); }
    asm volatile("" ::: "memory");
    __builtin_amdgcn_s_barrier();
    asm volatile("" ::: "memory");
    if (wid >= 2) {
#pragma unroll
        for (int st = 0; st < SC_D; ++st) SC_ISSUE(st, st);
    }
    for (int st = 0; st < 256; ++st) {
        if (wid == 1) { if ((st & 7) == 0 && st > 0) wait_counts8(readyc, st + SC_D, 255, lane, 4u); }
        else if (wid == 7) asm volatile("s_waitcnt vmcnt(10)" ::: "memory");
        else if (wid >= 2) asm volatile("s_waitcnt vmcnt(12)" ::: "memory");
        asm volatile("" ::: "memory");
        __builtin_amdgcn_s_barrier();
        asm volatile("" ::: "memory");
        if (wid >= 2) {
            const int nx = st + SC_D < 256 ? st + SC_D : 255;
            SC_ISSUE(nx, (st + SC_D) & 3);
        } else if (wid == 0) {
            const int u = u0 + st * 4;
            LAS const unsigned char* sb = lds + (st & 3) * SC_SLOT + lane * 16;
            unsigned char* svh = sv_home(p, u);
            bf16x8 Sb[4];
#pragma unroll
            for (int ks = 0; ks < 4; ++ks) Sb[ks] = pack8(S[2 * ks], S[2 * ks + 1]);
            const u32x4 u0v = *(LAS const u32x4*)(sb + 32768), u1v = *(LAS const u32x4*)(sb + 33792);
            const float al = *(LAS const float*)(lds + (st & 3) * SC_SLOT + 34816);
            bf16x8 wfr[16], kfr[16];
#pragma unroll
            for (int f = 0; f < 16; ++f) wfr[f] = *(LAS const bf16x8*)(sb + f * 1024);
#pragma unroll
            for (int f = 0; f < 16; ++f) kfr[f] = *(LAS const bf16x8*)(sb + 16384 + f * 1024);
            u32x4* sfr = (u32x4*)(svh + (size_t)s * 4096) + lane;
#pragma unroll
            for (int ks = 0; ks < 4; ++ks) sfr[ks * 64] = __builtin_bit_cast(u32x4, Sb[ks]);
            __builtin_amdgcn_sched_barrier(0);
            f32x4 vn[4];
#pragma unroll
            for (int mt = 0; mt < 4; ++mt) vn[mt] = (f32x4){0.f, 0.f, 0.f, 0.f};
#pragma unroll
            for (int ks = 0; ks < 4; ++ks)
#pragma unroll
                for (int mt = 0; mt < 4; ++mt) vn[mt] = MFMA16(wfr[mt * 4 + ks], Sb[ks], vn[mt]);
#pragma unroll
            for (int mt = 0; mt < 4; ++mt) {
                const unsigned lo = mt == 0 ? u0v.x : mt == 1 ? u0v.z : mt == 2 ? u1v.x : u1v.z;
                const unsigned hi = mt == 0 ? u0v.y : mt == 1 ? u0v.w : mt == 2 ? u1v.y : u1v.w;
                vn[mt][0] = __uint_as_float(lo << 16) - vn[mt][0]; vn[mt][1] = __uint_as_float(lo & 0xffff0000u) - vn[mt][1];
                vn[mt][2] = __uint_as_float(hi << 16) - vn[mt][2]; vn[mt][3] = __uint_as_float(hi & 0xffff0000u) - vn[mt][3];
            }
            bf16x8 Vb[2];
            Vb[0] = pack8(vn[0], vn[1]); Vb[1] = pack8(vn[2], vn[3]);
            u32x4* vfr = (u32x4*)(svh + 32768 + (size_t)s * 2048) + lane;
            vfr[0] = __builtin_bit_cast(u32x4, Vb[0]); vfr[64] = __builtin_bit_cast(u32x4, Vb[1]);
#pragma unroll
            for (int mt = 0; mt < 8; ++mt) S[mt] *= al;
#pragma unroll
            for (int ks = 0; ks < 2; ++ks)
#pragma unroll
                for (int mt = 0; mt < 8; ++mt) S[mt] = MFMA16(kfr[mt * 2 + ks], Vb[ks], S[mt]);
        }
    }
    if (wid >= 2) asm volatile("s_waitcnt vmcnt(0)" ::: "memory");
    else if (wid == 0) {
        float* sout = p.out + O_STP + ((size_t)(layer * 2 + bb) * 4 + h) * 16384;
#pragma unroll
        for (int mt = 0; mt < 8; ++mt)
#pragma unroll
            for (int e = 0; e < 4; ++e) sout[(size_t)(mt * 16 + 4 * g + e) * 128 + s * 16 + n] = S[mt][e];
    }
#undef SC_ISSUE
}
DI void phase_chunk_scan(const Params& p, int layer, unsigned char* smem, LAS unsigned char* lds) {
    const int b = bid_fresh();
    if (b < 64) {
        scan_prompt(p, layer, lds, tid_fresh(), b);
    } else {
        phase_chunk(p, layer, smem, 64, (int)gridDim.x - 64);
        const int tid = tid_fresh(), wid = tid >> 6, lane = tid & 63;
        unsigned* readyc = (unsigned*)(ws_fresh(p.ws) + OFF_FLAG) + layer * 528;
        for (int t = (b - 64) * 8 + wid; t < 512; t += (gridDim.x - 64) * 8) {
            const int sb = t >> 5, h = (t >> 3) & 3, s = t & 7;
            wait_count(readyc + 512 + sb, 4u);
            scan_task(p, layer, (512 + sb) * 4 + h, 1, p.state0 + ((size_t)(layer * 16 + sb) * 4 + h) * 16384,
                      p.out + O_STS + ((size_t)(layer * 16 + sb) * 4 + h) * 16384, s, lane);
        }
    }
}

DI void phase_out(const Params& p, int layer) {
    const int tid = tid_fresh(), wid = tid >> 6, lane = tid & 63, g = lane >> 4, n = lane & 15, bid = bid_fresh();
    const bf16_t* pz = (const bf16_t*)(ws_fresh(p.ws) + OFF_PZ);
    bf16_t* mixin = (bf16_t*)(p.out + O_Y);
    f32x4 gwv[8];
#pragma unroll
    for (int s = 0; s < 8; ++s) gwv[s] = *(const f32x4*)(p.gdn_nw + layer * 128 + s * 16 + 4 * g);
    for (int t = bid * 8 + wid; t < 4096 + 64; t += gridDim.x * 8) {
        int u, mt0; bool two;
        if (t < 4096) { u = t >> 1; mt0 = (t & 1) * 2; two = true; } else { u = 2048 + (t - 4096); mt0 = 0; two = false; }
        const int c = u >> 2, h = u & 3;
        int row0, nvalid;
        if (c < 512) { row0 = (c >> 8) * 16384 + (c & 255) * 64; nvalid = 64; } else { row0 = TP + (c - 512) * 16; nvalid = 16; }
        const unsigned char* frb = ws_fresh(p.ws) + OFF_FR + (size_t)u * FR_STRIDE;
        const u32x4* qgf = (const u32x4*)(frb + FR_QG) + lane;
        const u32x4* qkf = (const u32x4*)(frb + FR_QK) + lane;
        const unsigned char* svh = sv_home(p, u);
        const u32x4* sfr = (const u32x4*)svh + lane;
        const u32x4* vfr = (const u32x4*)(svh + 32768) + lane;
        u32x2 zv[2][8];
#pragma unroll
        for (int q = 0; q < 2; ++q) {
            const int r = (mt0 + q) * 16 + n;
            const size_t grow = (size_t)(row0 + ((r < nvalid && (q == 0 || two)) ? r : 0));
            const bf16_t* zr = pz + grow * 512 + h * 128 + 4 * g;
#pragma unroll
            for (int s = 0; s < 8; ++s) zv[q][s] = *(const u32x2*)(zr + s * 16);
        }
        bf16x8 qg[2][4], qk[2][2];
#pragma unroll
        for (int q = 0; q < 2; ++q) {
            const int mt = two ? mt0 + q : 0;
#pragma unroll
            for (int ks = 0; ks < 4; ++ks) qg[q][ks] = __builtin_bit_cast(bf16x8, qgf[(mt * 4 + ks) * 64]);
#pragma unroll
            for (int ks = 0; ks < 2; ++ks) qk[q][ks] = __builtin_bit_cast(bf16x8, qkf[(mt * 2 + ks) * 64]);
        }
        f32x4 o[2][8];
#pragma unroll
        for (int s = 0; s < 8; ++s) {
            bf16x8 sb[4], vb[2];
#pragma unroll
            for (int ks = 0; ks < 4; ++ks) sb[ks] = __builtin_bit_cast(bf16x8, sfr[(s * 4 + ks) * 64]);
#pragma unroll
            for (int ks = 0; ks < 2; ++ks) vb[ks] = __builtin_bit_cast(bf16x8, vfr[(s * 2 + ks) * 64]);
#pragma unroll
            for (int q = 0; q < 2; ++q) {
                f32x4 acc = {0.f, 0.f, 0.f, 0.f};
#pragma unroll
                for (int ks = 0; ks < 4; ++ks) acc = MFMA16(sb[ks], qg[q][ks], acc);
#pragma unroll
                for (int ks = 0; ks < 2; ++ks) acc = MFMA16(vb[ks], qk[q][ks], acc);
                o[q][s] = acc;
            }
        }
#pragma unroll
        for (int q = 0; q < 2; ++q) {
            float v = 0.f;
#pragma unroll
            for (int s = 0; s < 8; ++s) v += o[q][s][0] * o[q][s][0] + o[q][s][1] * o[q][s][1] + o[q][s][2] * o[q][s][2] + o[q][s][3] * o[q][s][3];
            v += __shfl_xor(v, 16); v += __shfl_xor(v, 32);
            const float rs = rsqrtf(v * (1.f / 128.f) + 1e-6f);
            const int r = (mt0 + q) * 16 + n;
            if (r < nvalid && (q == 0 || two)) {
                bf16_t* mr = mixin + (size_t)(row0 + r) * 1024 + h * 128 + 4 * g;
#pragma unroll
                for (int s = 0; s < 8; ++s) {
                    const float z0 = __uint_as_float(zv[q][s].x << 16), z1 = __uint_as_float(zv[q][s].x & 0xffff0000u), z2 = __uint_as_float(zv[q][s].y << 16), z3 = __uint_as_float(zv[q][s].y & 0xffff0000u);
                    const f32x4 ov = o[q][s] * rs * gwv[s];
                    u32x2 w; w.x = pk_bf16(ov[0] * silu_fast(z0), ov[1] * silu_fast(z1)); w.y = pk_bf16(ov[2] * silu_fast(z2), ov[3] * silu_fast(z3));
                    *(u32x2*)(mr + s * 16) = w;
                }
            }
        }
    }
}

#define XB_TMO      128
#define XB_XCNT(j)  (256  + 64 * (j))
#define XB_XSUB(j)  (1280 + 64 * (j))
#define XB_XGEN(j)  (2304 + 64 * (j))
#define XB_TOP      3328
#define XB_TOPGEN   3392
#define XCD_BAR_WORDS 3456
#define XB_SPIN_CAP (1u << 20)
DI unsigned xb_ld(unsigned* p)              { return __hip_atomic_load(p, __ATOMIC_RELAXED, __HIP_MEMORY_SCOPE_AGENT); }
DI unsigned xb_add(unsigned* p, unsigned v) { return __hip_atomic_fetch_add(p, v, __ATOMIC_RELAXED, __HIP_MEMORY_SCOPE_AGENT); }
DI unsigned xb_xcc_id() { return (unsigned)__builtin_amdgcn_s_getreg((3 << 11) | 20) & 0xFu; }
#define XB_SPIN(cond, bar) do { unsigned _sp = 0; while (cond) { __builtin_amdgcn_s_sleep(1); \
    if ((++_sp & 255u) == 0u) { if (xb_ld(&(bar)[XB_TMO])) break; if (_sp > XB_SPIN_CAP) { atomicAdd(&(bar)[XB_TMO], 1u); break; } } } } while (0)
struct XcdBarrier { unsigned* bar; unsigned x; volatile LAS unsigned* st; };
DI XcdBarrier xcd_barrier_post(unsigned* bar, volatile LAS unsigned* st) {
    XcdBarrier b; b.bar = bar; b.x = xb_xcc_id(); b.st = st;
    if (threadIdx.x == 0) (void)xb_add(&bar[XB_XCNT(b.x)], 1u);
    return b;
}
DI void xcd_barrier_complete(unsigned* bar, unsigned x, unsigned& nloc, unsigned& nx) {
    const unsigned G = gridDim.x * gridDim.y * gridDim.z;
    unsigned sum, cnt, mine, sp = 0u;
    for (;;) {
        sum = 0u; cnt = 0u; mine = 0u;
#pragma unroll
        for (unsigned j = 0; j < 16; ++j) { const unsigned c = xb_ld(&bar[XB_XCNT(j)]); sum += c; cnt += (c > 0u) ? 1u : 0u; mine = (j == x) ? c : mine; }
        if (sum == G) break;
        __builtin_amdgcn_s_sleep(1);
        if ((++sp & 255u) == 0u) { if (xb_ld(&bar[XB_TMO])) break; if (sp > XB_SPIN_CAP) { atomicAdd(&bar[XB_TMO], 1u); break; } }
    }
    nloc = mine > 0u ? mine : 1u; nx = cnt > 0u ? cnt : 1u;
}
DI void xcd_barrier(const XcdBarrier& b) {
    asm volatile("s_waitcnt vmcnt(0)" ::: "memory");
    __syncthreads();
    if (threadIdx.x == 0) {
        unsigned* bar = b.bar;
        asm volatile("" : "+s"(bar));
        __builtin_amdgcn_s_waitcnt(0);
        unsigned nloc = b.st[0], nx = b.st[1];
        if (nloc == 0u) { xcd_barrier_complete(bar, b.x, nloc, nx); b.st[0] = nloc; b.st[1] = nx; }
        const unsigned old = xb_add(&bar[XB_XSUB(b.x)], 1u);
        const unsigned gen = old / nloc;
        if (old + 1u == (gen + 1u) * nloc) {
            __builtin_amdgcn_fence(__ATOMIC_RELEASE, "agent");
            asm volatile("s_waitcnt vmcnt(0)" ::: "memory");
            const unsigned og = xb_add(&bar[XB_TOP], 1u);
            const unsigned tg = og / nx;
            if (og + 1u == (tg + 1u) * nx) xb_add(&bar[XB_TOPGEN], 1u);
            else XB_SPIN(xb_ld(&bar[XB_TOPGEN]) == tg, bar);
            __builtin_amdgcn_fence(__ATOMIC_ACQUIRE, "agent");
            xb_add(&bar[XB_XGEN(b.x)], 1u);
            asm volatile("s_waitcnt vmcnt(0)" ::: "memory");
        } else {
            XB_SPIN(xb_ld(&bar[XB_XGEN(b.x)]) == gen, bar);
            __builtin_amdgcn_fence(__ATOMIC_ACQUIRE, "agent");
            asm volatile("s_waitcnt vmcnt(0)" ::: "memory");
        }
    }
    __syncthreads();
}

__global__ void __launch_bounds__(512) mega(Params p) {
    extern __shared__ __attribute__((aligned(16))) unsigned char smem[];
    cg::grid_group grid = cg::this_grid();
    LAS unsigned char* lds = (LAS unsigned char*)smem;
    volatile LAS unsigned* xst = (volatile LAS unsigned*)(lds + LDS_BYTES - 16);
    if (threadIdx.x == 0) { xst[0] = 0u; xst[1] = 0u; }
    __syncthreads();
    const XcdBarrier xb = xcd_barrier_post((unsigned*)(ws_fresh(p.ws) + OFF_BAR), xst);

    phase_weights(p, smem, 0, 448, 0);
    row_phase<0>(p, 0, 0, smem);
    if (p.ws == nullptr) grid.sync();
    xcd_barrier(xb);
    for (int l = 0; l < 2; ++l) {
        {
            pg8::Gemm g{(const bf16_t*)(ws_fresh(p.ws) + OFF_XB), (const bf16_t*)(ws_fresh(p.ws) + OFF_WIN + l * SZ_WIN), TT, 3584, 1024};
            pg8::StaticOrder S; S.init(TT, 3584, 1024, gridDim.x, bid_fresh());
            EpiG1 e{(const float*)(ws_fresh(p.ws) + OFF_RSTD), (bf16_t*)(ws_fresh(p.ws) + OFF_PQKV), (bf16_t*)(ws_fresh(p.ws) + OFF_PSC), (bf16_t*)(ws_fresh(p.ws) + OFF_PZ)};
            pg8::gemm_phase(lds, g, S, e);
            if (l == 0) phase_weights(p, smem, 448, 1632, 14);
        }
        xcd_barrier(xb);
        phase_chunk_scan(p, l, smem, lds);
        xcd_barrier(xb);
        phase_out(p, l);
        xcd_barrier(xb);
        {
            pg8::Gemm g{(const bf16_t*)(p.out + O_Y), (const bf16_t*)(ws_fresh(p.ws) + OFF_WO + l * SZ_WO), TT, 1024, 1024};
            pg8::SplitOrder S; S.init(1024, 1024, gridDim.x, bid_fresh());
            EpiRawSplit e{(bf16_t*)(ws_fresh(p.ws) + OFF_RAW), (float*)(ws_fresh(p.ws) + OFF_PZ)};
            pg8::gemm_phase(lds, g, S, e);
        }
        xcd_barrier(xb);
        row_phase<1>(p, l, 0, smem);
        xcd_barrier(xb);
        {
            pg8::Gemm g{(const bf16_t*)(ws_fresh(p.ws) + OFF_XB), (const bf16_t*)(ws_fresh(p.ws) + OFF_WGU + l * SZ_WGU), TT, 5632, 1024};
            pg8::StaticOrder S; S.init(TT, 5632, 1024, gridDim.x, bid_fresh());
            EpiGU e{(const float*)(ws_fresh(p.ws) + OFF_RSTD), (bf16_t*)(ws_fresh(p.ws) + OFF_ACT)};
            pg8::gemm_phase(lds, g, S, e);
            if (l == 0) phase_weights(p, smem, 1632, 3264, 22);
        }
        xcd_barrier(xb);
        {
            pg8::Gemm g{(const bf16_t*)(ws_fresh(p.ws) + OFF_ACT), (const bf16_t*)(ws_fresh(p.ws) + OFF_WD + l * SZ_WD), TT, 1024, DFF};
            pg8::SplitOrder S; S.init(1024, DFF, gridDim.x, bid_fresh());
            EpiRawSplit e{(bf16_t*)(ws_fresh(p.ws) + OFF_RAW), (float*)(ws_fresh(p.ws) + OFF_PZ)};
            pg8::gemm_phase(lds, g, S, e);
        }
        xcd_barrier(xb);
        if (l == 0) { row_phase<2>(p, 0, 1, smem); xcd_barrier(xb); }
        else row_phase<3>(p, 1, 0, smem);
    }
}

extern "C" void kernel_launch(void* const* d_in, const int* in_sizes, int n_in, void* d_out, int out_size, void* d_ws, size_t ws_size,
                              hipStream_t stream) {
    static int grid_blocks = 0;
    if (!grid_blocks) {
        int dev = 0, cus = 0, per_cu = 0;
        hipGetDevice(&dev);
        hipDeviceGetAttribute(&cus, hipDeviceAttributeMultiprocessorCount, dev);
        hipFuncSetAttribute((const void*)mega, hipFuncAttributeMaxDynamicSharedMemorySize, LDS_BYTES);
        hipOccupancyMaxActiveBlocksPerMultiprocessor(&per_cu, mega, 512, LDS_BYTES);
        if (per_cu > 1) per_cu = 1;
        grid_blocks = cus * per_cu;
        if (grid_blocks < 128) { fprintf(stderr, "unexpected occupancy: cus=%d per_cu=%d\n", cus, per_cu); }
    }
    if (ws_size < WS_NEED) { fprintf(stderr, "workspace too small: %zu < %zu\n", ws_size, (size_t)WS_NEED); return; }
    Params p{};
    const float* const* in = (const float* const*)d_in;
    p.xp = in[0]; p.xs = in[1]; p.cache_conv = in[2]; p.state0 = in[3]; p.cache_sc = in[4]; p.n_mix_pre = in[5]; p.w_in = in[6];
    p.conv_w = in[7]; p.a_log = in[8]; p.dt_bias = in[9]; p.gdn_nw = in[10]; p.conv_sc_w = in[11]; p.w_o = in[12]; p.n_mix_post = in[13];
    p.n_ffn_pre = in[14]; p.w_gate = in[15]; p.w_up = in[16]; p.w_down = in[17]; p.n_ffn_post = in[18];
    p.out = (float*)d_out; p.ws = (unsigned char*)d_ws;
    hipMemsetAsync((unsigned char*)d_ws + OFF_BAR, 0, 32768, stream);
    void* args[] = {&p};
    hipError_t e = hipLaunchCooperativeKernel((const void*)mega, dim3(grid_blocks), dim3(512), args, LDS_BYTES, stream);
    if (e != hipSuccess) fprintf(stderr, "cooperative launch failed: %s (grid %d)\n", hipGetErrorString(e), grid_blocks);
}
```

```cpp
#include <hip/hip_runtime.h>
#include <hip/hip_cooperative_groups.h>
#include <cstdio>
namespace cg = cooperative_groups;

#define LAS __attribute__((address_space(3)))
typedef unsigned short bf16_t;
typedef short bf16x8 __attribute__((ext_vector_type(8)));
typedef float f32x4 __attribute__((ext_vector_type(4)));
typedef float f32x2 __attribute__((ext_vector_type(2)));
typedef unsigned u32x4 __attribute__((ext_vector_type(4)));
typedef unsigned u32x2 __attribute__((ext_vector_type(2)));
typedef __bf16 bf16v2 __attribute__((ext_vector_type(2)));
#define DI __device__ __forceinline__
DI int tid_fresh() { int t = threadIdx.x; asm volatile("" : "+v"(t)); return t; }
DI int bid_fresh() { int b = blockIdx.x; asm volatile("" : "+s"(b)); return b; }
DI unsigned char* ws_fresh(unsigned char* w) { asm volatile("" : "+s"(w)); return w; }

constexpr int DM = 1024, TT = 33024, TP = 32768, DFF = 2816, INDIM = 3592;
constexpr int NCHH = 2112;
constexpr int LDS_BYTES = 147456;

constexpr size_t SZ_WIN = (size_t)3584 * 1024 * 2, SZ_WO = (size_t)1024 * 1024 * 2, SZ_WGU = (size_t)5632 * 1024 * 2, SZ_WD = (size_t)1024 * 2816 * 2;
constexpr size_t OFF_WIN = 0;
constexpr size_t OFF_WO = OFF_WIN + 2 * SZ_WIN;
constexpr size_t OFF_WGU = OFF_WO + 2 * SZ_WO;
constexpr size_t OFF_WD = OFF_WGU + 2 * SZ_WGU;
constexpr size_t OFF_WBA = OFF_WD + 2 * SZ_WD;
constexpr size_t OFF_RSTD = OFF_WBA + 2 * 8 * 1024 * 4;
constexpr size_t OFF_BETA = OFF_RSTD + (size_t)TT * 4;
constexpr size_t OFF_GLOG = OFF_BETA + (size_t)TT * 16;
constexpr size_t OFF_AL = OFF_GLOG + (size_t)TT * 16;
constexpr size_t OFF_BAR = OFF_AL + 16384;
constexpr size_t OFF_FLAG = OFF_BAR + 16384;
constexpr size_t OFF_SPARE = OFF_FLAG + 16384;
constexpr size_t OFF_XB = OFF_SPARE + (size_t)18 * 196608;
constexpr size_t OFF_PQKV = OFF_XB + (size_t)TT * 1024 * 2;
constexpr size_t OFF_PSC = OFF_PQKV + (size_t)TT * 1536 * 2;
constexpr size_t OFF_PZ = OFF_PSC + (size_t)TT * 1536 * 2;
constexpr size_t OFF_ACT = OFF_PQKV;
constexpr size_t OFF_FR = OFF_PZ + (size_t)TT * 512 * 2;
constexpr size_t FR_STRIDE = 74752, FR_W = 0, FR_KT = 16384, FR_QG = 32768, FR_QK = 49152, FR_U = 57344, FR_META = 73728;
constexpr size_t OFF_RAW = OFF_FR;
constexpr size_t WS_NEED = OFF_FR + (size_t)NCHH * FR_STRIDE;
static_assert((size_t)TT * 1024 * 4 <= (size_t)NCHH * FR_STRIDE, "raw fits");
static_assert(WS_NEED <= (size_t)536870912, "workspace");

constexpr size_t O_Y = 0;
constexpr size_t O_CONVP = (size_t)TT * 1024;
constexpr size_t O_STP = O_CONVP + 2 * 2 * 3 * 1536;
constexpr size_t O_SCP = O_STP + (size_t)2 * 2 * 4 * 16384;
constexpr size_t O_CONVS = O_SCP + 2 * 2 * 2 * 512;
constexpr size_t O_STS = O_CONVS + (size_t)2 * 16 * 3 * 1536;
constexpr size_t O_SCS = O_STS + (size_t)2 * 16 * 4 * 16384;

struct Params {
    const float *xp, *xs, *cache_conv, *state0, *cache_sc, *n_mix_pre, *w_in, *conv_w, *a_log, *dt_bias, *gdn_nw, *conv_sc_w, *w_o,
        *n_mix_post, *n_ffn_pre, *w_gate, *w_up, *w_down, *n_ffn_post;
    float* out;
    unsigned char* ws;
};

DI float bf2f(bf16_t v) { return __uint_as_float(((unsigned)v) << 16); }
DI unsigned pk_bf16(float lo, float hi) {
    f32x2 v = {lo, hi};
    bf16v2 r = __builtin_convertvector(v, bf16v2);
    return __builtin_bit_cast(unsigned, r);
}
DI bf16_t f2bf(float x) { return (bf16_t)(pk_bf16(x, 0.f) & 0xffffu); }
DI float silu_f(float x) { return x / (1.f + __expf(-x)); }
DI float wave_sum(float v) {
    v += __builtin_bit_cast(float, __builtin_amdgcn_update_dpp(0, __builtin_bit_cast(int, v), 0xB1, 0xf, 0xf, true));
    v += __builtin_bit_cast(float, __builtin_amdgcn_update_dpp(0, __builtin_bit_cast(int, v), 0x4E, 0xf, 0xf, true));
    v += __builtin_bit_cast(float, __builtin_amdgcn_update_dpp(0, __builtin_bit_cast(int, v), 0x141, 0xf, 0xf, true));
    v += __builtin_bit_cast(float, __builtin_amdgcn_update_dpp(0, __builtin_bit_cast(int, v), 0x140, 0xf, 0xf, true));
    v += __builtin_bit_cast(float, __builtin_amdgcn_update_dpp(0, __builtin_bit_cast(int, v), 0x142, 0xa, 0xf, false));
    v += __builtin_bit_cast(float, __builtin_amdgcn_update_dpp(0, __builtin_bit_cast(int, v), 0x143, 0xc, 0xf, false));
    return __builtin_bit_cast(float, __builtin_amdgcn_readlane(__builtin_bit_cast(int, v), 63));
}
DI bf16x8 pack8(const f32x4& a, const f32x4& b) {
    u32x4 p; p.x = pk_bf16(a[0], a[1]); p.y = pk_bf16(a[2], a[3]); p.z = pk_bf16(b[0], b[1]); p.w = pk_bf16(b[2], b[3]);
    return __builtin_bit_cast(bf16x8, p);
}

DI unsigned char* sv_home(const Params& p, int u) {
    const int c = u >> 2, h = u & 3;
    if (c < 512) {
        const int n = c & 255, b = c >> 8;
        if (n > 0) return ws_fresh(p.ws) + OFF_PQKV + (size_t)(b * 16384 + (n - 1) * 64) * 3072 + (size_t)h * 49152;
        return ws_fresh(p.ws) + OFF_SPARE + (size_t)b * 196608 + (size_t)h * 49152;
    }
    return ws_fresh(p.ws) + OFF_SPARE + (size_t)(2 + c - 512) * 196608 + (size_t)h * 49152;
}
DI void wait_count(unsigned* f, unsigned need) {
    unsigned sp = 0;
    while (__hip_atomic_load(f, __ATOMIC_RELAXED, __HIP_MEMORY_SCOPE_AGENT) < need) { __builtin_amdgcn_s_sleep(2); if (++sp > (1u << 22)) break; }
    __builtin_amdgcn_fence(__ATOMIC_ACQUIRE, "agent");
    asm volatile("s_waitcnt vmcnt(0)" ::: "memory");
}
DI void wait_counts8(unsigned* f, int first, int last_valid, int lane, unsigned need) {
    int idx = first + (lane & 7); if (idx > last_valid) idx = last_valid;
    unsigned sp = 0;
    for (;;) {
        const unsigned v = __hip_atomic_load(f + idx, __ATOMIC_RELAXED, __HIP_MEMORY_SCOPE_AGENT);
        if (__all(v >= need)) break;
        __builtin_amdgcn_s_sleep(2);
        if (++sp > (1u << 22)) break;
    }
    __builtin_amdgcn_fence(__ATOMIC_ACQUIRE, "agent");
    asm volatile("s_waitcnt vmcnt(0)" ::: "memory");
}
#define MFMA16(a, b, c) __builtin_amdgcn_mfma_f32_16x16x32_bf16((a), (b), (c), 0, 0, 0)

namespace pg8 {
constexpr int BM = 256, BK = 64, HALF = 128, HTB = HALF * BK * 2, STAGE_BYTES = 8 * HTB, NXCD = 8, WGM = 8;
DI int lds_byte(int r, int c) { const int st = (r >> 4) * 2 + (c >> 5), rr = r & 15, cc = c & 31, ob = rr * 64 + cc * 2; return st * 1024 + (ob ^ (((ob >> 9) & 1) << 5)); }
DI void stage_rc(int b, int& R, int& C) { const int st = b / 1024, sb = b % 1024, swz = sb ^ (((sb >> 9) & 1) << 5); R = (st >> 1) * 16 + swz / 64; C = (st & 1) * 32 + (swz % 64) / 2; }
DI int perm32(int rho) { const int n = rho >> 4, i = rho & 15; return 8 * (i >> 2) + 4 * n + (i & 3); }
struct Unit { int pm, pn, nt; unsigned kofs; };
struct Gemm { const bf16_t* A; const bf16_t* Bt; int M, N, K; };
struct StaticOrder {
    int nM, nN, nwg, G, c, ntf;
    DI void init(int M, int N, int K, int G_, int c_) { nM = M / BM; nN = N / BM; nwg = nM * nN; G = G_; c = c_; ntf = K / BK; }
    DI void map(int wgid, Unit& u) const {
        { const int q = nwg / NXCD, r = nwg % NXCD, xcd = wgid % NXCD, off = wgid / NXCD; wgid = (xcd < r ? xcd * (q + 1) : r * (q + 1) + (xcd - r) * q) + off; }
        const int nig = WGM * nN, gid = wgid / nig, fm = gid * WGM, gsz = (nM - fm) < WGM ? (nM - fm) : WGM;
        u.pm = fm + ((wgid % nig) % gsz); u.pn = (wgid % nig) / gsz; u.nt = ntf; u.kofs = 0u;
    }
    DI bool next(int i, Unit& u) const {
        const long L = (long)i * G + c; if (L >= nwg) return false;
        map((int)L, u); return true;
    }
};
struct SplitOrder : StaticOrder {
    int nsub;
    DI void init(int N, int K, int G_, int c_) { StaticOrder::init(TP, N, K, G_, c_); nsub = nN * (K / 256); }
    DI bool next(int i, Unit& u) const {
        const long L = (long)i * G + c;
        if (L < nwg) { map((int)L, u); return true; }
        const int j = (int)(L - nwg); if (j >= nsub) return false;
        u.pm = 128; u.pn = j % nN; u.nt = 4; u.kofs = (unsigned)(j / nN) * 512u; return true;
    }
};
template <class Epi, class Sched, bool ALIGN_EPI = true>
DI void gemm_phase(LAS unsigned char* lds, const Gemm g, const Sched& S, const Epi& E) {
    const int tid = tid_fresh(), wid = __builtin_amdgcn_readfirstlane(tid >> 6), lane = tid & 63, wr = wid >> 2, wc = wid & 3, fr = lane & 15, fq = lane >> 4;
    const int K = g.K;
    unsigned voffA[2], voffB[2];
#pragma unroll
    for (int i = 0; i < 2; ++i) { int R, C; stage_rc(tid * 16 + i * 8192, R, C); const int Rb = ((R & ~31) + perm32(R & 31));
        voffA[i] = (unsigned)(R * K + C) * 2u; voffB[i] = (unsigned)(Rb * K + C) * 2u; }
    const size_t kstep = (size_t)(BK * 2);
    const size_t hstep = (size_t)HALF * K * 2;
    const size_t tstep = 2 * hstep;
    const unsigned ldsw = (unsigned)wid * 1024u;
    const int aoff = lds_byte(wr * 64 + fr, fq * 8), boff = lds_byte(wc * 32 + fr, fq * 8);
#define PG8_SA(b, h) (((b) * 2 + (h)) * HTB)
#define PG8_SB(b, h) ((4 + (b) * 2 + (h)) * HTB)
#define PG8_STAGE(bufoff, gbase, voff) do { _Pragma("unroll") for (int _i = 0; _i < 2; ++_i) \
        __builtin_amdgcn_global_load_lds((const unsigned*)((const char*)(gbase) + (voff)[_i]), (LAS unsigned*)(lds + (bufoff) + ldsw + _i * 8192), 16, 0, 0); } while (0)
#define PG8_LDA(dst, b, h) do { _Pragma("unroll") for (int m = 0; m < 4; ++m) _Pragma("unroll") for (int k = 0; k < 2; ++k) dst[m][k] = *(const LAS bf16x8*)(lds + PG8_SA(b, h) + aoff + m * 2048 + k * 1024); } while (0)
#define PG8_LDB(dst, b, h) do { _Pragma("unroll") for (int n = 0; n < 2; ++n) _Pragma("unroll") for (int k = 0; k < 2; ++k) dst[n][k] = *(const LAS bf16x8*)(lds + PG8_SB(b, h) + boff + n * 2048 + k * 1024); } while (0)
#define PG8_MMA(ai, bj, At, Bt) do { __builtin_amdgcn_s_setprio(1); _Pragma("unroll") for (int m = 0; m < 4; ++m) _Pragma("unroll") for (int n = 0; n < 2; ++n) _Pragma("unroll") for (int k = 0; k < 2; ++k) \
        acc[ai][bj][m][n] = __builtin_amdgcn_mfma_f32_16x16x32_bf16(Bt[n][k], At[m][k], acc[ai][bj][m][n], 0, 0, 0); __builtin_amdgcn_s_setprio(0); } while (0)
#define PG8_WAIT_V(n) asm volatile("s_waitcnt vmcnt(" #n ")" ::: "memory")
#define PG8_WAIT_L(n) asm volatile("s_waitcnt lgkmcnt(" #n ")" ::: "memory")
#define PG8_BAR __builtin_amdgcn_s_barrier()
#define PG8_SCHED __builtin_amdgcn_sched_barrier(0)
    Unit cur, nxt; int ui = 0;
    if (!S.next(0, cur)) return;
    f32x4 acc[2][2][4][2];
#pragma unroll
    for (int a = 0; a < 2; ++a)
#pragma unroll
        for (int b = 0; b < 2; ++b)
#pragma unroll
            for (int m = 0; m < 4; ++m)
#pragma unroll
                for (int n = 0; n < 2; ++n) acc[a][b][m][n] = (f32x4){0.f, 0.f, 0.f, 0.f};
    bf16x8 At[4][2], B0[2][2], B1[2][2];
    const char* cA = (const char*)g.A + (size_t)cur.pm * tstep + cur.kofs; const char* cB = (const char*)g.Bt + (size_t)cur.pn * tstep + cur.kofs;
    PG8_STAGE(PG8_SB(0, 0), cB, voffB); PG8_STAGE(PG8_SB(0, 1), cB + hstep, voffB); PG8_STAGE(PG8_SA(0, 0), cA, voffA); PG8_STAGE(PG8_SA(0, 1), cA + hstep, voffA);
    if (wr == 1) PG8_BAR;
    PG8_WAIT_V(2); PG8_BAR;
    PG8_STAGE(PG8_SB(1, 0), cB + kstep, voffB); PG8_STAGE(PG8_SA(1, 0), cA + kstep, voffA); PG8_STAGE(PG8_SB(1, 1), cB + hstep + kstep, voffB);
    PG8_WAIT_V(6); PG8_BAR;
    for (;;) {
        const bool has_next = S.next(ui + 1, nxt);
        const char* nA = has_next ? (const char*)g.A + (size_t)nxt.pm * tstep + nxt.kofs : cA; const char* nB = has_next ? (const char*)g.Bt + (size_t)nxt.pn * tstep + nxt.kofs : cB;
        const int nt = cur.nt;
        for (int t = 0; t < nt; t += 2) {
            const bool last = (t == nt - 2);
            const char* a1 = cA + (size_t)(t + 1) * kstep;
            const char* a2 = last ? nA : cA + (size_t)(t + 2) * kstep; const char* b2 = last ? nB : cB + (size_t)(t + 2) * kstep;
            const char* a3 = a2 + kstep; const char* b3 = b2 + kstep;
            PG8_LDB(B0, 0, 0); PG8_LDB(B1, 0, 1); PG8_SCHED; PG8_LDA(At, 0, 0); PG8_STAGE(PG8_SA(1, 1), a1 + hstep, voffA);
            PG8_WAIT_V(8); PG8_WAIT_L(0); PG8_BAR; PG8_MMA(0, 0, At, B0); PG8_MMA(0, 1, At, B1); PG8_BAR; PG8_SCHED;
            PG8_LDA(At, 0, 1); PG8_STAGE(PG8_SB(0, 0), b2, voffB); PG8_STAGE(PG8_SB(0, 1), b2 + hstep, voffB); PG8_STAGE(PG8_SA(0, 0), a2, voffA);
            PG8_WAIT_V(8); PG8_WAIT_L(0); PG8_BAR; PG8_MMA(1, 0, At, B0); PG8_MMA(1, 1, At, B1); PG8_BAR; PG8_SCHED;
            PG8_LDB(B0, 1, 0); PG8_LDB(B1, 1, 1); PG8_SCHED; PG8_LDA(At, 1, 0); PG8_STAGE(PG8_SA(0, 1), a2 + hstep, voffA);
            PG8_WAIT_V(8); PG8_WAIT_L(0); PG8_BAR; PG8_MMA(0, 0, At, B0); PG8_MMA(0, 1, At, B1); PG8_BAR; PG8_SCHED;
            PG8_LDA(At, 1, 1); PG8_STAGE(PG8_SB(1, 0), b3, voffB); PG8_STAGE(PG8_SB(1, 1), b3 + hstep, voffB); PG8_STAGE(PG8_SA(1, 0), a3, voffA);
            PG8_WAIT_V(8); PG8_WAIT_L(0); PG8_BAR; PG8_MMA(1, 0, At, B0); PG8_MMA(1, 1, At, B1); PG8_BAR; PG8_SCHED;
        }
        if constexpr (ALIGN_EPI) { if (wr == 0) PG8_BAR; }
        E(acc, cur, wr, wc, fr, fq);
        if (!has_next) break;
#pragma unroll
        for (int a = 0; a < 2; ++a)
#pragma unroll
            for (int b = 0; b < 2; ++b)
#pragma unroll
                for (int m = 0; m < 4; ++m)
#pragma unroll
                    for (int n = 0; n < 2; ++n) acc[a][b][m][n] = (f32x4){0.f, 0.f, 0.f, 0.f};
        cur = nxt; cA = nA; cB = nB; ++ui;
        if constexpr (ALIGN_EPI) { if (wr == 1) PG8_BAR; }
    }
    PG8_WAIT_V(0);
    if constexpr (!ALIGN_EPI) { if (wr == 0) PG8_BAR; }
    PG8_BAR;
#undef PG8_SA
#undef PG8_SB
#undef PG8_STAGE
#undef PG8_LDA
#undef PG8_LDB
#undef PG8_MMA
#undef PG8_WAIT_V
#undef PG8_WAIT_L
#undef PG8_BAR
#undef PG8_SCHED
}
}

using pg8::Unit;
typedef f32x4 AccT[2][2][4][2];

struct EpiG1 {
    const float* rstd; bf16_t *pqkv, *psc, *pz;
    DI void operator()(const AccT& acc, const Unit& u, int wr, int wc, int fr, int fq) const {
        bf16_t* base; int ldc, colt;
        if (u.pn < 6) { base = pqkv; ldc = 1536; colt = u.pn * 256; }
        else if (u.pn < 8) { base = pz; ldc = 512; colt = (u.pn - 6) * 256; }
        else { base = psc; ldc = 1536; colt = (u.pn - 8) * 256; }
        const int row0 = u.pm * 256 + wr * 64 + fr, col0 = colt + wc * 32 + 8 * fq;
#pragma unroll
        for (int ai = 0; ai < 2; ++ai)
#pragma unroll
            for (int m = 0; m < 4; ++m) {
                const int row = row0 + ai * 128 + m * 16;
                bf16_t* rowp = base + (size_t)row * ldc + col0;
#pragma unroll
                for (int bj = 0; bj < 2; ++bj) {
                    const f32x4 v0 = acc[ai][bj][m][0], v1 = acc[ai][bj][m][1];
                    u32x4 w; w.x = pk_bf16(v0[0], v0[1]); w.y = pk_bf16(v0[2], v0[3]); w.z = pk_bf16(v1[0], v1[1]); w.w = pk_bf16(v1[2], v1[3]);
                    *(u32x4*)(rowp + bj * 128) = w;
                }
            }
    }
};
struct EpiRawSplit {
    bf16_t* C; float* racc;
    DI void operator()(const AccT& acc, const Unit& u, int wr, int wc, int fr, int fq) const {
        const int row0 = u.pm * 256 + wr * 64 + fr, col0 = u.pn * 256 + wc * 32 + 8 * fq;
        if (u.pm < 128) {
#pragma unroll
            for (int ai = 0; ai < 2; ++ai)
#pragma unroll
                for (int m = 0; m < 4; ++m) {
                    bf16_t* rowp = C + (size_t)(row0 + ai * 128 + m * 16) * 1024 + col0;
#pragma unroll
                    for (int bj = 0; bj < 2; ++bj) {
                        const f32x4 v0 = acc[ai][bj][m][0], v1 = acc[ai][bj][m][1];
                        u32x4 w; w.x = pk_bf16(v0[0], v0[1]); w.y = pk_bf16(v0[2], v0[3]); w.z = pk_bf16(v1[0], v1[1]); w.w = pk_bf16(v1[2], v1[3]);
                        *(u32x4*)(rowp + bj * 128) = w;
                    }
                }
        } else {
#pragma unroll
            for (int ai = 0; ai < 2; ++ai)
#pragma unroll
                for (int m = 0; m < 4; ++m) {
                    float* rowp = racc + (size_t)(u.kofs >> 9) * 262144 + (size_t)(row0 - TP + ai * 128 + m * 16) * 1024 + col0;
#pragma unroll
                    for (int bj = 0; bj < 2; ++bj) { *(f32x4*)(rowp + bj * 128) = acc[ai][bj][m][0]; *(f32x4*)(rowp + bj * 128 + 4) = acc[ai][bj][m][1]; }
                }
        }
    }
};
struct EpiGU {
    const float* rstd; bf16_t* act;
    DI void operator()(const AccT& acc, const Unit& u, int wr, int wc, int fr, int fq) const {
        const int row0 = u.pm * 256 + wr * 64 + fr, col0 = u.pn * 128 + wc * 32 + 8 * fq;
#pragma unroll
        for (int ai = 0; ai < 2; ++ai)
#pragma unroll
            for (int m = 0; m < 4; ++m) {
                const int row = row0 + ai * 128 + m * 16;
                float o[8];
#pragma unroll
                for (int n = 0; n < 2; ++n)
#pragma unroll
                    for (int i = 0; i < 4; ++i) { const float gv = acc[ai][0][m][n][i], uv = acc[ai][1][m][n][i]; o[n * 4 + i] = gv * __builtin_amdgcn_rcpf(1.f + __expf(-gv)) * uv; }
                u32x4 w; w.x = pk_bf16(o[0], o[1]); w.y = pk_bf16(o[2], o[3]); w.z = pk_bf16(o[4], o[5]); w.w = pk_bf16(o[6], o[7]);
                *(u32x4*)(act + (size_t)row * DFF + col0) = w;
            }
    }
};

DI void wtile(const float* src, int ld, int k0, int n0, const float* gain, bf16_t* dst, int K, int nd0, unsigned char* smem) {
    bf16_t* tl = (bf16_t*)smem;
    const int tid = tid_fresh();
    {
        const int kk = tid >> 2, cs = (tid & 3) * 16;
        const float gsc = gain ? gain[k0 + kk] : 1.f;
        const float* sp = src + (size_t)(k0 + kk) * ld + n0 + cs;
        f32x4 v[4];
#pragma unroll
        for (int q = 0; q < 4; ++q) v[q] = *(const f32x4*)(sp + 4 * q);
#pragma unroll
        for (int q = 0; q < 4; ++q)
#pragma unroll
            for (int i = 0; i < 4; ++i) tl[(cs + 4 * q + i) * 136 + kk] = f2bf(v[q][i] * gsc);
    }
    __syncthreads();
    {
        const int n = tid >> 3, ks = (tid & 7) * 16;
        const u32x4 v0 = *(const u32x4*)(tl + n * 136 + ks), v1 = *(const u32x4*)(tl + n * 136 + ks + 8);
        bf16_t* dp = dst + (size_t)(nd0 + n) * K + k0 + ks;
        *(u32x4*)dp = v0; *(u32x4*)(dp + 8) = v1;
    }
    __syncthreads();
}
DI void phase_weights(const Params& p, unsigned char* smem) {
    constexpr int PER = 448 + 128 + 704 + 352;
    const int bid = bid_fresh();
    for (int j = bid; j < 2 * PER; j += gridDim.x) {
        const int l = j / PER; int r = j % PER;
        if (r < 448) {
            const int kt = r / 56, nt = r % 56, nd0 = nt * 64, n0 = nd0 < 2048 ? nd0 : nd0 + 8;
            wtile(p.w_in + (size_t)l * 1024 * INDIM, INDIM, kt * 128, n0, p.n_mix_pre + l * 1024, (bf16_t*)(ws_fresh(p.ws) + OFF_WIN + l * SZ_WIN), 1024, nd0, smem);
        } else if (r < 448 + 128) {
            r -= 448; const int kt = r / 16, nt = r % 16;
            wtile(p.w_o + (size_t)l * 1024 * 1024, 1024, kt * 128, nt * 64, nullptr, (bf16_t*)(ws_fresh(p.ws) + OFF_WO + l * SZ_WO), 1024, nt * 64, smem);
        } else if (r < 448 + 128 + 704) {
            r -= 448 + 128; const int kt = r / 88, nt = r % 88, nd0 = nt * 64, pp = nd0 / 256, s = (nd0 % 256) / 128, jj = nd0 % 128;
            const float* src = (s ? p.w_up : p.w_gate) + (size_t)l * 1024 * DFF;
            wtile(src, DFF, kt * 128, pp * 128 + jj, p.n_ffn_pre + l * 1024, (bf16_t*)(ws_fresh(p.ws) + OFF_WGU + l * SZ_WGU), 1024, nd0, smem);
        } else {
            r -= 448 + 128 + 704; const int kt = r / 16, nt = r % 16;
            wtile(p.w_down + (size_t)l * DFF * 1024, 1024, kt * 128, nt * 64, nullptr, (bf16_t*)(ws_fresh(p.ws) + OFF_WD + l * SZ_WD), DFF, nt * 64, smem);
        }
    }
}

template <int MODE>
DI void row_phase(const Params& p, int layer, int lnext, unsigned char* smem) {
    const int tid = tid_fresh(), wid = tid >> 6, lane = tid & 63, bid = bid_fresh();
    float* wl = (float*)smem;
    if (MODE == 0 || MODE == 2) {
        for (int i = tid; i < 8192; i += 512) {
            const int k = i >> 3, j = i & 7;
            wl[j * 1024 + k] = p.n_mix_pre[lnext * 1024 + k] * p.w_in[((size_t)lnext * 1024 + k) * INDIM + 2048 + j];
        }
        __syncthreads();
    }
    const bf16_t* raw = (const bf16_t*)(ws_fresh(p.ws) + OFF_RAW);
    bf16_t* xa = (bf16_t*)(ws_fresh(p.ws) + OFF_XB);
    float* rstd = (float*)(ws_fresh(p.ws) + OFF_RSTD);
    const float* gain = MODE == 1 ? p.n_mix_post + layer * 1024 : p.n_ffn_post + layer * 1024;
    f32x4 gn[4];
    if (MODE != 0) {
#pragma unroll
        for (int hh = 0; hh < 2; ++hh) { gn[2 * hh] = *(const f32x4*)(gain + hh * 512 + lane * 8); gn[2 * hh + 1] = *(const f32x4*)(gain + hh * 512 + lane * 8 + 4); }
    }
    constexpr int NR = 2;
    const int gw = bid * 8 + wid, nw = gridDim.x * 8;
    for (int rb = gw * NR; rb < TT; rb += nw * NR) {
        f32x4 x[NR][4];
        u32x4 rw[NR][2];
#pragma unroll
        for (int q = 0; q < NR; ++q) {
            const int r = rb + q;
            if (MODE == 0) {
                const float* res = r < TP ? p.xp + (size_t)r * 1024 : p.xs + (size_t)(r - TP) * 1024;
#pragma unroll
                for (int hh = 0; hh < 2; ++hh) { x[q][2 * hh] = *(const f32x4*)(res + hh * 512 + lane * 8); x[q][2 * hh + 1] = *(const f32x4*)(res + hh * 512 + lane * 8 + 4); }
            } else {
#pragma unroll
                for (int hh = 0; hh < 2; ++hh) {
                    const u32x4 v = *(const u32x4*)(xa + (size_t)r * 1024 + hh * 512 + lane * 8);
                    const float inv = 1.f / rstd[r];
                    x[q][2 * hh] = (f32x4){__uint_as_float(v.x << 16), __uint_as_float(v.x & 0xffff0000u), __uint_as_float(v.y << 16), __uint_as_float(v.y & 0xffff0000u)} * inv;
                    x[q][2 * hh + 1] = (f32x4){__uint_as_float(v.z << 16), __uint_as_float(v.z & 0xffff0000u), __uint_as_float(v.w << 16), __uint_as_float(v.w & 0xffff0000u)} * inv;
                    rw[q][hh] = __builtin_nontemporal_load((const u32x4*)(raw + (size_t)r * 1024 + hh * 512 + lane * 8));
                }
            }
        }
#pragma unroll
        for (int q = 0; q < NR; ++q) {
            const int r = rb + q;
            if (MODE != 0) {
                f32x4 f[4];
                if (rb >= TP) {
                    const float* ra = (const float*)(ws_fresh(p.ws) + OFF_PZ) + (size_t)(r - TP) * 1024 + lane * 8;
#pragma unroll
                    for (int i = 0; i < 4; ++i) f[i] = (f32x4){0.f, 0.f, 0.f, 0.f};
                    constexpr int NKC = MODE == 1 ? 4 : 11;
#pragma unroll 4
                    for (int kc = 0; kc < NKC; ++kc) {
                        const float* rk = ra + (size_t)kc * 262144;
                        const f32x4 t0 = *(const f32x4*)rk, t1 = *(const f32x4*)(rk + 4), t2 = *(const f32x4*)(rk + 512), t3 = *(const f32x4*)(rk + 516);
                        f[0] += t0; f[1] += t1; f[2] += t2; f[3] += t3;
                    }
                } else {
#pragma unroll
                    for (int hh = 0; hh < 2; ++hh) {
                        const u32x4 v = rw[q][hh];
                        f[2 * hh] = (f32x4){__uint_as_float(v.x << 16), __uint_as_float(v.x & 0xffff0000u), __uint_as_float(v.y << 16), __uint_as_float(v.y & 0xffff0000u)};
                        f[2 * hh + 1] = (f32x4){__uint_as_float(v.z << 16), __uint_as_float(v.z & 0xffff0000u), __uint_as_float(v.w << 16), __uint_as_float(v.w & 0xffff0000u)};
                    }
                }
                float ss = 0.f;
#pragma unroll
                for (int i = 0; i < 4; ++i) ss += f[i][0] * f[i][0] + f[i][1] * f[i][1] + f[i][2] * f[i][2] + f[i][3] * f[i][3];
                ss = wave_sum(ss);
                const float rs = rsqrtf(ss * (1.f / 1024.f) + 1e-6f);
#pragma unroll
                for (int i = 0; i < 4; ++i) x[q][i] += f[i] * rs * gn[i];
            }
            if (MODE == 3) {
                float* yo = p.out + O_Y + (size_t)r * 1024;
#pragma unroll
                for (int hh = 0; hh < 2; ++hh) { __builtin_nontemporal_store(x[q][2 * hh], (f32x4*)(yo + hh * 512 + lane * 8)); __builtin_nontemporal_store(x[q][2 * hh + 1], (f32x4*)(yo + hh * 512 + lane * 8 + 4)); }
            } else {
                float ss = 0.f;
#pragma unroll
                for (int i = 0; i < 4; ++i) ss += x[q][i][0] * x[q][i][0] + x[q][i][1] * x[q][i][1] + x[q][i][2] * x[q][i][2] + x[q][i][3] * x[q][i][3];
                ss = wave_sum(ss);
                const float rs = rsqrtf(ss * (1.f / 1024.f) + 1e-6f);
                if (lane == 0) rstd[r] = rs;
#pragma unroll
                for (int hh = 0; hh < 2; ++hh) {
                    const f32x4 n0 = x[q][2 * hh] * rs, n1 = x[q][2 * hh + 1] * rs;
                    u32x4 w; w.x = pk_bf16(n0[0], n0[1]); w.y = pk_bf16(n0[2], n0[3]); w.z = pk_bf16(n1[0], n1[1]); w.w = pk_bf16(n1[2], n1[3]);
                    *(u32x4*)(xa + (size_t)r * 1024 + hh * 512 + lane * 8) = w;
                }
                if (MODE == 0 || MODE == 2) {
                    float d[8];
#pragma unroll
                    for (int j = 0; j < 8; ++j) {
                        float a = 0.f;
#pragma unroll
                        for (int i = 0; i < 4; ++i) { const f32x4 w = *(const f32x4*)(wl + j * 1024 + (i >> 1) * 512 + lane * 8 + (i & 1) * 4); a += x[q][i][0] * w[0] + x[q][i][1] * w[1] + x[q][i][2] * w[2] + x[q][i][3] * w[3]; }
                        d[j] = wave_sum(a) * rs;
                    }
                    if (lane < 4) {
                        const float braw = lane == 0 ? d[0] : lane == 1 ? d[1] : lane == 2 ? d[2] : d[3];
                        const float araw = lane == 0 ? d[4] : lane == 1 ? d[5] : lane == 2 ? d[6] : d[7];
                        const float beta = 1.f / (1.f + __expf(-braw));
                        const float xv = araw + p.dt_bias[lnext * 4 + lane];
                        const float sp = xv > 20.f ? xv : log1pf(__expf(xv));
                        const float g = -__expf(p.a_log[lnext * 4 + lane]) * sp;
                        ((float*)(ws_fresh(p.ws) + OFF_BETA))[r * 4 + lane] = beta;
                        ((float*)(ws_fresh(p.ws) + OFF_GLOG))[r * 4 + lane] = g;
                    }
                }
            }
        }
    }
}

constexpr int KNS = 136;
constexpr int TBS = 72;
constexpr int C_QN = 0;
constexpr int C_KN = C_QN + 17408;
constexpr int C_VBT = C_KN + 17408;
constexpr int C_KBT = C_VBT + 18432;
constexpr int C_SM = C_KBT + 18432;
constexpr int C_AM = C_SM + 2048;
constexpr int C_TF = C_AM + 16384;
constexpr int C_TB = C_TF + 16384;
constexpr int C_QKL = C_TB + 9216;
constexpr int C_WL = C_QKL + 9216;
static_assert(C_WL + 17408 <= LDS_BYTES - 16, "lds");
DI f32x4 bflo4(const u32x4& v) { return (f32x4){__uint_as_float(v.x << 16), __uint_as_float(v.x & 0xffff0000u), __uint_as_float(v.y << 16), __uint_as_float(v.y & 0xffff0000u)}; }
DI f32x4 bfhi4(const u32x4& v) { return (f32x4){__uint_as_float(v.z << 16), __uint_as_float(v.z & 0xffff0000u), __uint_as_float(v.w << 16), __uint_as_float(v.w & 0xffff0000u)}; }
DI float row16_sum(float v) {
    v += __builtin_bit_cast(float, __builtin_amdgcn_update_dpp(0, __builtin_bit_cast(int, v), 0xB1, 0xf, 0xf, true));
    v += __builtin_bit_cast(float, __builtin_amdgcn_update_dpp(0, __builtin_bit_cast(int, v), 0x4E, 0xf, 0xf, true));
    v += __builtin_bit_cast(float, __builtin_amdgcn_update_dpp(0, __builtin_bit_cast(int, v), 0x141, 0xf, 0xf, true));
    v += __builtin_bit_cast(float, __builtin_amdgcn_update_dpp(0, __builtin_bit_cast(int, v), 0x140, 0xf, 0xf, true));
    return v;
}
DI float silu_fast(float x) { return x * __builtin_amdgcn_rcpf(1.f + __expf(-x)); }

DI void write_frags_rowmajor(const bf16_t* X, int ldx, int KS, int nfr, const float* rowscale, __amdgpu_buffer_rsrc_t rs, unsigned dofs, int t0, int nthr) {
    for (int it = t0; it < nfr * 64; it += nthr) {
        const int f = it >> 6, l = it & 63, mt = f / KS, ks = f % KS, m = mt * 16 + (l & 15), g = l >> 4;
        const bf16_t* rp = X + m * ldx + ks * 32 + 4 * g;
        const u32x2 lo = *(const u32x2*)rp, hi = *(const u32x2*)(rp + 16);
        u32x4 o;
        if (rowscale) {
            const float s = rowscale[m];
            o.x = pk_bf16(__uint_as_float(lo.x << 16) * s, __uint_as_float(lo.x & 0xffff0000u) * s);
            o.y = pk_bf16(__uint_as_float(lo.y << 16) * s, __uint_as_float(lo.y & 0xffff0000u) * s);
            o.z = pk_bf16(__uint_as_float(hi.x << 16) * s, __uint_as_float(hi.x & 0xffff0000u) * s);
            o.w = pk_bf16(__uint_as_float(hi.y << 16) * s, __uint_as_float(hi.y & 0xffff0000u) * s);
        } else { o.x = lo.x; o.y = lo.y; o.z = hi.x; o.w = hi.y; }
        __builtin_amdgcn_raw_buffer_store_b128(o, rs, dofs + (unsigned)it * 16u, 0, 16);
    }
}

DI void phase_chunk(const Params& p, int layer, unsigned char* smem, int first_block, int nblk) {
    const int tid = tid_fresh(), wid = tid >> 6, lane = tid & 63, bid = bid_fresh();
    bf16_t* QN = (bf16_t*)(smem + C_QN);
    bf16_t* KN = (bf16_t*)(smem + C_KN);
    bf16_t* VBT = (bf16_t*)(smem + C_VBT);
    bf16_t* KBT = (bf16_t*)(smem + C_KBT);
    bf16_t* QKL = (bf16_t*)(smem + C_QKL);
    bf16_t* TB = (bf16_t*)(smem + C_TB);
    float* SM = (float*)(smem + C_SM);
    float *GC = SM, *BETA = SM + 64, *EG = SM + 128, *EGL = SM + 192, *QS = SM + 256, *KS_ = SM + 320, *BE = SM + 384;
    float* AM = (float*)(smem + C_AM);
    float* TF = (float*)(smem + C_TF);
    bf16_t* WL = (bf16_t*)(smem + C_WL);
    const bf16_t* pqkv = (const bf16_t*)(ws_fresh(p.ws) + OFF_PQKV);
    const bf16_t* psc = (const bf16_t*)(ws_fresh(p.ws) + OFF_PSC);
    bf16_t* mixin = (bf16_t*)(p.out + O_Y);
    const float* betaA = (const float*)(ws_fresh(p.ws) + OFF_BETA);
    const float* glogA = (const float*)(ws_fresh(p.ws) + OFF_GLOG);

    unsigned* readyc = (unsigned*)(ws_fresh(p.ws) + OFF_FLAG) + layer * 528;
    int pending_c = -1;
    for (int o = bid - first_block; o < NCHH; o += nblk) {
        const int u = o < 2048 ? ((((o >> 2) & 1) * 256 + (o >> 3)) * 4 + (o & 3)) : o;
        const int c = u >> 2, h = u & 3;
        int row0, nvalid, sb = 0; bool first, lastc, prompt = c < 512;
        if (prompt) { const int b = c >> 8, n = c & 255; row0 = b * 16384 + n * 64; nvalid = 64; first = n == 0; lastc = n == 255; sb = b; }
        else { sb = c - 512; row0 = TP + sb * 16; nvalid = 16; first = true; lastc = true; }
        unsigned char* frb = ws_fresh(p.ws) + OFF_FR + (size_t)u * FR_STRIDE;
        const __amdgpu_buffer_rsrc_t frr = __builtin_amdgcn_make_buffer_rsrc(frb, 0, (int)FR_STRIDE, 0x00020000);

        const int rg = tid / 48, cg = tid % 48, which = cg >> 4, c0 = (cg & 15) * 8, col0 = which * 512 + h * 128 + c0, r0 = rg * 8;
        u32x4 raw[11];
        const bool use_cache = (tid < 384) && rg == 0 && first && !prompt;
        if (tid < 384) {
#pragma unroll
            for (int i = 0; i < 11; ++i) {
                int rr = r0 - 3 + i;
                if (rr >= nvalid) rr = 0;
                if (rr < 0 && first) rr = 0;
                raw[i] = *(const u32x4*)(pqkv + (size_t)(row0 + rr) * 1536 + col0);
            }
        }
        if (wid == 7) {
            const int r = lane;
            float gv = 0.f, bv = 0.f;
            if (r < nvalid) { gv = glogA[(size_t)(row0 + r) * 4 + h]; bv = betaA[(size_t)(row0 + r) * 4 + h]; }
            float cs = gv;
#pragma unroll
            for (int o = 1; o < 64; o <<= 1) { const float t = __shfl_up(cs, o); if (lane >= o) cs += t; }
            const float gl = __shfl(cs, 63);
            const float egv = __expf(cs); GC[r] = cs; BETA[r] = bv; EG[r] = egv; BE[r] = bv * egv; EGL[r] = __expf(gl - cs);
            const float alx = __expf(gl);
            if (r == 0) __hip_atomic_store((float*)(ws_fresh(p.ws) + OFF_AL) + u, alx, __ATOMIC_RELAXED, __HIP_MEMORY_SCOPE_AGENT);
            { const unsigned ab = __float_as_uint(alx); __builtin_amdgcn_raw_buffer_store_b128((u32x4){ab, ab, ab, ab}, frr, (unsigned)(FR_META + lane * 16), 0, 16); }
        }
        asm volatile("s_waitcnt vmcnt(0)" ::: "memory");
        __syncthreads();
        if (pending_c >= 0 && tid == 0) __hip_atomic_fetch_add(readyc + pending_c, 1u, __ATOMIC_RELAXED, __HIP_MEMORY_SCOPE_AGENT);
        if (tid < 384) {
            const float* cw = p.conv_w + layer * 4 * 1536 + col0;
            f32x4 wv[4][2];
#pragma unroll
            for (int i = 0; i < 4; ++i) { wv[i][0] = *(const f32x4*)(cw + i * 1536); wv[i][1] = *(const f32x4*)(cw + i * 1536 + 4); }
            f32x4 xin[11][2];
#pragma unroll
            for (int i = 0; i < 11; ++i) {
                xin[i][0] = bflo4(raw[i]); xin[i][1] = bfhi4(raw[i]);
                if (i < 3 && rg == 0 && first) {
                    if (use_cache) {
                        const float* cp = p.cache_conv + ((size_t)(layer * 16 + sb) * 3 + i) * 1536 + col0;
                        xin[i][0] = *(const f32x4*)cp; xin[i][1] = *(const f32x4*)(cp + 4);
                    } else { xin[i][0] = (f32x4){0.f, 0.f, 0.f, 0.f}; xin[i][1] = xin[i][0]; }
                }
            }
            if (lastc && r0 + 8 == ((nvalid + 7) & ~7) ) {
                float* co = prompt ? p.out + O_CONVP + ((size_t)(layer * 2 + sb) * 3) * 1536 + col0 : p.out + O_CONVS + ((size_t)(layer * 16 + sb) * 3) * 1536 + col0;
                const int jl = nvalid - 1 - r0;
#pragma unroll
                for (int i = 0; i < 3; ++i) { *(f32x4*)(co + i * 1536) = xin[jl + 1 + i][0]; *(f32x4*)(co + i * 1536 + 4) = xin[jl + 1 + i][1]; }
            }
            float yv[8][8];
#pragma unroll
            for (int j = 0; j < 8; ++j) {
                const bool valid = r0 + j < nvalid;
                const f32x4 a0 = wv[0][0] * xin[j][0] + wv[1][0] * xin[j + 1][0] + wv[2][0] * xin[j + 2][0] + wv[3][0] * xin[j + 3][0];
                const f32x4 a1 = wv[0][1] * xin[j][1] + wv[1][1] * xin[j + 1][1] + wv[2][1] * xin[j + 2][1] + wv[3][1] * xin[j + 3][1];
#pragma unroll
                for (int e = 0; e < 4; ++e) { yv[j][e] = valid ? silu_fast(a0[e]) : 0.f; yv[j][4 + e] = valid ? silu_fast(a1[e]) : 0.f; }
            }
            if (which < 2) {
                bf16_t* dstn = (which ? KN : QN);
#pragma unroll
                for (int j = 0; j < 8; ++j) {
                    float ss = 0.f;
#pragma unroll
                    for (int e = 0; e < 8; ++e) ss += yv[j][e] * yv[j][e];
                    ss = row16_sum(ss);
                    const float sc = rsqrtf(ss + 1e-6f) * (which ? 1.f : 0.08838834764831845f);
#pragma unroll
                    for (int e = 0; e < 8; ++e) yv[j][e] *= sc;
                    u32x4 w; w.x = pk_bf16(yv[j][0], yv[j][1]); w.y = pk_bf16(yv[j][2], yv[j][3]); w.z = pk_bf16(yv[j][4], yv[j][5]); w.w = pk_bf16(yv[j][6], yv[j][7]);
                    *(u32x4*)(dstn + (r0 + j) * KNS + c0) = w;
                }
            }
            if (which >= 1) {
                bf16_t* dstt = (which == 1 ? KBT : VBT);
                const float* scl = (which == 1 ? BE : BETA);
                float sc8[8];
#pragma unroll
                for (int j = 0; j < 8; ++j) sc8[j] = scl[r0 + j];
#pragma unroll
                for (int e = 0; e < 8; ++e) {
                    u32x4 w; w.x = pk_bf16(yv[0][e] * sc8[0], yv[1][e] * sc8[1]); w.y = pk_bf16(yv[2][e] * sc8[2], yv[3][e] * sc8[3]);
                    w.z = pk_bf16(yv[4][e] * sc8[4], yv[5][e] * sc8[5]); w.w = pk_bf16(yv[6][e] * sc8[6], yv[7][e] * sc8[7]);
                    *(u32x4*)(dstt + (c0 + e) * TBS + r0) = w;
                }
            }
        } else {
#pragma unroll 1
            for (int kb = 0; kb < 2; ++kb) {
                u32x4 scv[2][4], shv[2][4], sbv[2][2];
#pragma unroll
                for (int k2 = 0; k2 < 2; ++k2) {
                    const int it = (tid - 384) + 128 * (kb * 2 + k2), sr0 = (it >> 4) * 2, ch0 = h * 128 + (it & 15) * 8;
#pragma unroll
                    for (int i = 0; i < 4; ++i) {
                        int rr = sr0 - 2 + i;
                        if (rr >= nvalid) rr = 0;
                        if (rr < 0 && first) rr = 0;
                        const bf16_t* rp = psc + (size_t)(row0 + rr) * 1536 + ch0;
                        scv[k2][i] = *(const u32x4*)(rp + 512); shv[k2][i] = *(const u32x4*)(rp + 1024);
                        if (i >= 2) sbv[k2][i - 2] = *(const u32x4*)rp;
                    }
                }
#pragma unroll
                for (int k2 = 0; k2 < 2; ++k2) {
                    const int it = (tid - 384) + 128 * (kb * 2 + k2), sr0 = (it >> 4) * 2, ch0 = h * 128 + (it & 15) * 8;
                    if (sr0 < nvalid) {
                        const float* cw = p.conv_sc_w + layer * 3 * 512 + ch0;
                        f32x4 wv[3][2];
#pragma unroll
                        for (int i = 0; i < 3; ++i) { wv[i][0] = *(const f32x4*)(cw + i * 512); wv[i][1] = *(const f32x4*)(cw + i * 512 + 4); }
                        f32x4 pr[4][2];
#pragma unroll
                        for (int i = 0; i < 4; ++i) {
                            const int rr = sr0 - 2 + i;
                            if (rr < 0 && first) {
                                if (prompt) { pr[i][0] = (f32x4){0.f, 0.f, 0.f, 0.f}; pr[i][1] = pr[i][0]; }
                                else { const float* cp = p.cache_sc + ((size_t)(layer * 16 + sb) * 2 + (rr + 2)) * 512 + ch0; pr[i][0] = *(const f32x4*)cp; pr[i][1] = *(const f32x4*)(cp + 4); }
                            } else { pr[i][0] = bflo4(scv[k2][i]) * bflo4(shv[k2][i]); pr[i][1] = bfhi4(scv[k2][i]) * bfhi4(shv[k2][i]); }
                        }
#pragma unroll
                        for (int j = 0; j < 2; ++j) {
                            const u32x4 bvv = sbv[k2][j];
                            const f32x4 y0 = bflo4(bvv) * (wv[0][0] * pr[j][0] + wv[1][0] * pr[j + 1][0] + wv[2][0] * pr[j + 2][0]);
                            const f32x4 y1 = bfhi4(bvv) * (wv[0][1] * pr[j][1] + wv[1][1] * pr[j + 1][1] + wv[2][1] * pr[j + 2][1]);
                            u32x4 w; w.x = pk_bf16(y0[0], y0[1]); w.y = pk_bf16(y0[2], y0[3]); w.z = pk_bf16(y1[0], y1[1]); w.w = pk_bf16(y1[2], y1[3]);
                            *(u32x4*)(mixin + (size_t)(row0 + sr0 + j) * 1024 + 512 + ch0) = w;
                        }
                        if (lastc && sr0 == nvalid - 2) {
                            float* co = prompt ? p.out + O_SCP + ((size_t)(layer * 2 + sb) * 2) * 512 + ch0 : p.out + O_SCS + ((size_t)(layer * 16 + sb) * 2) * 512 + ch0;
                            *(f32x4*)co = pr[2][0]; *(f32x4*)(co + 4) = pr[2][1]; *(f32x4*)(co + 512) = pr[3][0]; *(f32x4*)(co + 516) = pr[3][1];
                        }
                    }
                }
            }
        }
        __syncthreads();
        const int tidb = tid_fresh(), widb = tidb >> 6, laneb = tidb & 63;
        for (int job = widb; job < 32; job += 8) {
            const int isqk = job >> 4, mi = (job >> 2) & 3, nj = job & 3;
            const int g = laneb >> 4, n = laneb & 15;
            if (mi < nj) {
#pragma unroll
                for (int e = 0; e < 4; ++e) { bf16_t* dst = (isqk ? QKL : TB) + (mi * 16 + 4 * g + e) * TBS + nj * 16 + n; *dst = 0; }
                continue;
            }
            const bf16_t* Arow = (isqk ? QN : KN) + (mi * 16 + n) * KNS + g * 8;
            const bf16_t* Brow = KN + (nj * 16 + n) * KNS + g * 8;
            f32x4 acc = {0.f, 0.f, 0.f, 0.f};
#pragma unroll
            for (int ks = 0; ks < 4; ++ks) {
                const bf16x8 a = *(const bf16x8*)(Arow + ks * 32), b = *(const bf16x8*)(Brow + ks * 32);
                acc = MFMA16(a, b, acc);
            }
            const int j = nj * 16 + n; const float gj = GC[j];
            if (isqk) {
#pragma unroll
                for (int e = 0; e < 4; ++e) {
                    const int i = mi * 16 + 4 * g + e;
                    const float v = (i >= j) ? acc[e] * __expf(GC[i] - gj) : 0.f; QKL[i * TBS + j] = f2bf(v);
                }
            } else {
                f32x4 v;
#pragma unroll
                for (int e = 0; e < 4; ++e) { const int i = mi * 16 + 4 * g + e; v[e] = (i > j) ? acc[e] * BETA[i] * __expf(GC[i] - gj) : 0.f; }
                *(f32x4*)(AM + j * 64 + mi * 16 + 4 * g) = v;
            }
        }
        __syncthreads();
        if (widb == 0) {
            const int b = laneb >> 4, cx = laneb & 15;
            const float* Ab = AM + (16 * b) * 64 + 16 * b;
            float x[16];
#pragma unroll
            for (int i = 0; i < 16; ++i) {
                float a = (i == cx) ? 1.f : 0.f;
#pragma unroll
                for (int j = 0; j < i; ++j) a -= Ab[j * 64 + i] * x[j];
                x[i] = a;
            }
#pragma unroll
            for (int i = 0; i < 16; ++i) { TF[(16 * b + i) * 64 + 16 * b + cx] = x[i]; TB[(16 * b + i) * TBS + 16 * b + cx] = f2bf(x[i]); }
        } else if (widb >= 4) {
            const int t0 = tidb - 256;
            write_frags_rowmajor(QN, KNS, 4, 16, EG, frr, (unsigned)FR_QG, t0, 256);
            write_frags_rowmajor(QKL, TBS, 2, 8, nullptr, frr, (unsigned)FR_QK, t0, 256);
            for (int it = t0; it < 16 * 64; it += 256) {
                const int f = it >> 6, l = it & 63, mt = f >> 1, ks = f & 1, m = mt * 16 + (l & 15), g = l >> 4;
                float v[8];
#pragma unroll
                for (int e = 0; e < 8; ++e) { const int j = ks * 32 + 16 * (e >> 2) + 4 * g + (e & 3); v[e] = bf2f(KN[j * KNS + m]) * EGL[j]; }
                u32x4 o; o.x = pk_bf16(v[0], v[1]); o.y = pk_bf16(v[2], v[3]); o.z = pk_bf16(v[4], v[5]); o.w = pk_bf16(v[6], v[7]);
                __builtin_amdgcn_raw_buffer_store_b128(o, frr, (unsigned)(FR_KT + it * 16), 0, 16);
            }
        }
        __syncthreads();
#pragma unroll
        for (int d = 1; d < 4; ++d) {
            if (widb < 4 - d) {
                const int b = widb, bi = b + d, g = laneb >> 4, n = laneb & 15;
                f32x4 acc = {0.f, 0.f, 0.f, 0.f};
                for (int k = b; k < bi; ++k) {
#pragma unroll
                    for (int ks = 0; ks < 4; ++ks) {
                        const float av = AM[(16 * k + 4 * ks + g) * 64 + 16 * bi + n];
                        const float bv = TF[(16 * k + 4 * ks + g) * 64 + 16 * b + n];
                        acc = __builtin_amdgcn_mfma_f32_16x16x4f32(av, bv, acc, 0, 0, 0);
                    }
                }
                f32x4 res = {0.f, 0.f, 0.f, 0.f};
#pragma unroll
                for (int e = 0; e < 4; ++e) {
                    const float dv = TF[(16 * bi + n) * 64 + 16 * bi + 4 * g + e];
                    res = __builtin_amdgcn_mfma_f32_16x16x4f32(dv, acc[e], res, 0, 0, 0);
                }
#pragma unroll
                for (int e = 0; e < 4; ++e) { const int i = 16 * bi + 4 * g + e; TF[i * 64 + 16 * b + n] = -res[e]; TB[i * TBS + 16 * b + n] = f2bf(-res[e]); }
            }
            __syncthreads();
        }
        {
            const int g = laneb >> 4, n = laneb & 15;
            bf16x8 ta[4][2];
#pragma unroll
            for (int mt = 0; mt < 4; ++mt)
#pragma unroll
                for (int ks = 0; ks < 2; ++ks) ta[mt][ks] = *(const bf16x8*)(TB + (mt * 16 + n) * TBS + ks * 32 + g * 8);
            f32x4 uo[4], wo[4];
#pragma unroll
            for (int mt = 0; mt < 4; ++mt) { uo[mt] = (f32x4){0.f, 0.f, 0.f, 0.f}; wo[mt] = (f32x4){0.f, 0.f, 0.f, 0.f}; }
#pragma unroll
            for (int ks = 0; ks < 2; ++ks) {
                const bf16x8 bu = *(const bf16x8*)(VBT + (widb * 16 + n) * TBS + ks * 32 + g * 8);
                const bf16x8 bw = *(const bf16x8*)(KBT + (widb * 16 + n) * TBS + ks * 32 + g * 8);
#pragma unroll
                for (int mt = 0; mt < 4; ++mt) { uo[mt] = MFMA16(ta[mt][ks], bu, uo[mt]); wo[mt] = MFMA16(ta[mt][ks], bw, wo[mt]); }
            }
            u32x4 a, b2;
            a.x = pk_bf16(uo[0][0], uo[0][1]); a.y = pk_bf16(uo[0][2], uo[0][3]); a.z = pk_bf16(uo[1][0], uo[1][1]); a.w = pk_bf16(uo[1][2], uo[1][3]);
            b2.x = pk_bf16(uo[2][0], uo[2][1]); b2.y = pk_bf16(uo[2][2], uo[2][3]); b2.z = pk_bf16(uo[3][0], uo[3][1]); b2.w = pk_bf16(uo[3][2], uo[3][3]);
            const unsigned uofs = (unsigned)(FR_U + (widb * 64 + laneb) * 32);
            __builtin_amdgcn_raw_buffer_store_b128(a, frr, uofs, 0, 16); __builtin_amdgcn_raw_buffer_store_b128(b2, frr, uofs + 16u, 0, 16);
#pragma unroll
            for (int mt = 0; mt < 4; ++mt)
#pragma unroll
                for (int e = 0; e < 4; ++e) WL[(mt * 16 + 4 * g + e) * KNS + widb * 16 + n] = f2bf(wo[mt][e]);
        }
        __syncthreads();
        write_frags_rowmajor(WL, KNS, 4, 16, nullptr, frr, (unsigned)FR_W, tidb, 512);
        pending_c = c;
    }
    asm volatile("s_waitcnt vmcnt(0)" ::: "memory");
    __syncthreads();
    if (pending_c >= 0 && tid == 0) __hip_atomic_fetch_add(readyc + pending_c, 1u, __ATOMIC_RELAXED, __HIP_MEMORY_SCOPE_AGENT);
}

DI void scan_task(const Params& p, int layer, int u0, int nsteps, const float* s0, float* sout, int s, int lane) {
    const int g = lane >> 4, n = lane & 15;
    f32x4 S[8];
#pragma unroll
    for (int mt = 0; mt < 8; ++mt)
#pragma unroll
        for (int e = 0; e < 4; ++e) S[mt][e] = s0 ? s0[(size_t)(mt * 16 + 4 * g + e) * 128 + s * 16 + n] : 0.f;
    const float* alA = (const float*)(ws_fresh(p.ws) + OFF_AL);
    for (int st = 0; st < nsteps; ++st) {
        const int u = u0 + st * 4;
        const unsigned char* frb = ws_fresh(p.ws) + OFF_FR + (size_t)u * FR_STRIDE;
        const u32x4* wf = (const u32x4*)(frb + FR_W) + lane;
        const u32x4* kf = (const u32x4*)(frb + FR_KT) + lane;
        const u32x4* uf = (const u32x4*)(frb + FR_U + (size_t)(s * 64 + lane) * 32);
        bf16x8 Sb[4];
#pragma unroll
        for (int ks = 0; ks < 4; ++ks) Sb[ks] = pack8(S[2 * ks], S[2 * ks + 1]);
        u32x4* sfr = (u32x4*)(sv_home(p, u) + (size_t)s * 4096) + lane;
#pragma unroll
        for (int ks = 0; ks < 4; ++ks) sfr[ks * 64] = __builtin_bit_cast(u32x4, Sb[ks]);
        const u32x4 u0v = uf[0], u1v = uf[1];
        f32x4 vn[4];
#pragma unroll
        for (int mt = 0; mt < 4; ++mt) {
            f32x4 acc = {0.f, 0.f, 0.f, 0.f};
#pragma unroll
            for (int ks = 0; ks < 4; ++ks) acc = MFMA16(__builtin_bit_cast(bf16x8, wf[(mt * 4 + ks) * 64]), Sb[ks], acc);
            const unsigned lo = mt == 0 ? u0v.x : mt == 1 ? u0v.z : mt == 2 ? u1v.x : u1v.z;
            const unsigned hi = mt == 0 ? u0v.y : mt == 1 ? u0v.w : mt == 2 ? u1v.y : u1v.w;
            vn[mt][0] = __uint_as_float(lo << 16) - acc[0]; vn[mt][1] = __uint_as_float(lo & 0xffff0000u) - acc[1];
            vn[mt][2] = __uint_as_float(hi << 16) - acc[2]; vn[mt][3] = __uint_as_float(hi & 0xffff0000u) - acc[3];
        }
        bf16x8 Vb[2];
        Vb[0] = pack8(vn[0], vn[1]); Vb[1] = pack8(vn[2], vn[3]);
        u32x4* vfr = (u32x4*)(sv_home(p, u) + 32768 + (size_t)s * 2048) + lane;
        vfr[0] = __builtin_bit_cast(u32x4, Vb[0]); vfr[64] = __builtin_bit_cast(u32x4, Vb[1]);
        const float al = alA[u];
#pragma unroll
        for (int mt = 0; mt < 8; ++mt) {
            S[mt] *= al;
#pragma unroll
            for (int ks = 0; ks < 2; ++ks) S[mt] = MFMA16(__builtin_bit_cast(bf16x8, kf[(mt * 2 + ks) * 64]), Vb[ks], S[mt]);
        }
    }
#pragma unroll
    for (int mt = 0; mt < 8; ++mt)
#pragma unroll
        for (int e = 0; e < 4; ++e) sout[(size_t)(mt * 16 + 4 * g + e) * 128 + s * 16 + n] = S[mt][e];
}
constexpr int SC_SLOT = 35840, SC_D = 3;
DI void scan_prompt(const Params& p, int layer, LAS unsigned char* lds, int tid, int b) {
    const int wid = __builtin_amdgcn_readfirstlane(tid >> 6), lane = tid & 63, g = lane >> 4, n = lane & 15;
    const int xcd = b & 7, s = b >> 3, bb = xcd >> 2, h = xcd & 3;
    const int u0 = (bb * 256) * 4 + h;
    const unsigned char* fr0 = ws_fresh(p.ws) + OFF_FR + (size_t)u0 * FR_STRIDE;
    const size_t stepB = 4 * FR_STRIDE;
    unsigned* readyc = (unsigned*)(ws_fresh(p.ws) + OFF_FLAG) + layer * 528 + bb * 256;
#define SC_ISSUE(st, slot) do { const unsigned char* _f = fr0 + (size_t)(st) * stepB; \
        _Pragma("unroll") for (int _i = 0; _i < 6; ++_i) { const int _q = (wid - 2) * 6 + _i; if (_q < 35) { \
            const unsigned char* _src = _q < 32 ? _f + _q * 1024 + lane * 16 : _q < 34 ? _f + FR_U + (size_t)(s * 64 + lane) * 32 + (_q - 32) * 16 : _f + FR_META + lane * 16; \
            __builtin_amdgcn_global_load_lds((const unsigned*)_src, (LAS unsigned*)(lds + (slot) * SC_SLOT + _q * 1024), 16, 0, 0); } } } while (0)
    f32x4 S[8];
#pragma unroll
    for (int mt = 0; mt < 8; ++mt) S[mt] = (f32x4){0.f, 0.f, 0.f, 0.f};
    if (wid == 1) { wait_counts8(readyc, 0, 255, lane, 4u); wait_counts8(readyc, 3, 255, lane, 4u); }
    asm volatile("" ::: "memory");
    __builtin_amdgcn_s_barrier();
    asm volatile("" ::: "memory");
    if (wid >= 2) {
#pragma unroll
        for (int st = 0; st < SC_D; ++st) SC_ISSUE(st, st);
    }
    if (wid == 7) asm volatile("s_waitcnt vmcnt(10)" ::: "memory");
    else if (wid >= 2) asm volatile("s_waitcnt vmcnt(12)" ::: "memory");
    asm volatile("" ::: "memory");
    __builtin_amdgcn_s_barrier();
    asm volatile("" ::: "memory");
    if (wid >= 2) SC_ISSUE(SC_D, SC_D & 3);
    bf16x8 wfr[16]; u32x4 u0v = {0u, 0u, 0u, 0u}, u1v = {0u, 0u, 0u, 0u}; float al = 0.f;
    if (wid == 0) {
        LAS const unsigned char* sb = lds + lane * 16;
        u0v = *(LAS const u32x4*)(sb + 32768); u1v = *(LAS const u32x4*)(sb + 33792); al = *(LAS const float*)(lds + 34816);
#pragma unroll
        for (int f = 0; f < 16; ++f) wfr[f] = *(LAS const bf16x8*)(sb + f * 1024);
    }
    for (int st = 0; st < 256; ++st) {
        const int k = st + 1;
        if (wid != 0) {
            if (wid == 1) { if ((k & 7) == 0 && k + SC_D < 256) wait_counts8(readyc, k + SC_D, 255, lane, 4u); }
            else if (wid == 7) asm volatile("s_waitcnt vmcnt(10)" ::: "memory");
            else asm volatile("s_waitcnt vmcnt(12)" ::: "memory");
            asm volatile("" ::: "memory");
            __builtin_amdgcn_s_barrier();
            asm volatile("" ::: "memory");
            if (wid >= 2) { const int nx = k + SC_D < 256 ? k + SC_D : 255; SC_ISSUE(nx, (k + SC_D) & 3); }
        } else {
            const int u = u0 + st * 4;
            LAS const unsigned char* sb = lds + (st & 3) * SC_SLOT + lane * 16;
            unsigned char* svh = sv_home(p, u);
            bf16x8 Sb[4];
#pragma unroll
            for (int ks = 0; ks < 4; ++ks) Sb[ks] = pack8(S[2 * ks], S[2 * ks + 1]);
            u32x4* sfr = (u32x4*)(svh + (size_t)s * 4096) + lane;
#pragma unroll
            for (int ks = 0; ks < 4; ++ks) sfr[ks * 64] = __builtin_bit_cast(u32x4, Sb[ks]);
            f32x4 vn[4];
#pragma unroll
            for (int mt = 0; mt < 4; ++mt) vn[mt] = (f32x4){0.f, 0.f, 0.f, 0.f};
#pragma unroll
            for (int ks = 0; ks < 4; ++ks)
#pragma unroll
                for (int mt = 0; mt < 4; ++mt) vn[mt] = MFMA16(wfr[mt * 4 + ks], Sb[ks], vn[mt]);
            __builtin_amdgcn_sched_barrier(0);
            bf16x8 kfr[16];
#pragma unroll
            for (int f = 0; f < 16; ++f) kfr[f] = *(LAS const bf16x8*)(sb + 16384 + f * 1024);
#pragma unroll
            for (int mt = 0; mt < 4; ++mt) {
                const unsigned lo = mt == 0 ? u0v.x : mt == 1 ? u0v.z : mt == 2 ? u1v.x : u1v.z;
                const unsigned hi = mt == 0 ? u0v.y : mt == 1 ? u0v.w : mt == 2 ? u1v.y : u1v.w;
                vn[mt][0] = __uint_as_float(lo << 16) - vn[mt][0]; vn[mt][1] = __uint_as_float(lo & 0xffff0000u) - vn[mt][1];
                vn[mt][2] = __uint_as_float(hi << 16) - vn[mt][2]; vn[mt][3] = __uint_as_float(hi & 0xffff0000u) - vn[mt][3];
            }
            bf16x8 Vb[2];
            Vb[0] = pack8(vn[0], vn[1]); Vb[1] = pack8(vn[2], vn[3]);
            u32x4* vfr = (u32x4*)(svh + 32768 + (size_t)s * 2048) + lane;
            vfr[0] = __builtin_bit_cast(u32x4, Vb[0]); vfr[64] = __builtin_bit_cast(u32x4, Vb[1]);
            const float alc = al;
            asm volatile("s_waitcnt lgkmcnt(0)" ::: "memory");
            __builtin_amdgcn_sched_barrier(0);
            __builtin_amdgcn_s_barrier();
            asm volatile("" ::: "memory");
            __builtin_amdgcn_sched_barrier(0);
            if (k < 256) {
                LAS const unsigned char* sn = lds + (k & 3) * SC_SLOT + lane * 16;
                u0v = *(LAS const u32x4*)(sn + 32768); u1v = *(LAS const u32x4*)(sn + 33792); al = *(LAS const float*)(lds + (k & 3) * SC_SLOT + 34816);
#pragma unroll
                for (int f = 0; f < 16; ++f) wfr[f] = *(LAS const bf16x8*)(sn + f * 1024);
            }
            __builtin_amdgcn_sched_barrier(0);
#pragma unroll
            for (int mt = 0; mt < 8; ++mt) S[mt] *= alc;
#pragma unroll
            for (int ks = 0; ks < 2; ++ks)
#pragma unroll
                for (int mt = 0; mt < 8; ++mt) S[mt] = MFMA16(kfr[mt * 2 + ks], Vb[ks], S[mt]);
        }
    }
    if (wid >= 2) asm volatile("s_waitcnt vmcnt(0)" ::: "memory");
    else if (wid == 0) {
        float* sout = p.out + O_STP + ((size_t)(layer * 2 + bb) * 4 + h) * 16384;
#pragma unroll
        for (int mt = 0; mt < 8; ++mt)
#pragma unroll
            for (int e = 0; e < 4; ++e) sout[(size_t)(mt * 16 + 4 * g + e) * 128 + s * 16 + n] = S[mt][e];
    }
#undef SC_ISSUE
}
DI void phase_chunk_scan(const Params& p, int layer, unsigned char* smem, LAS unsigned char* lds) {
    const int b = bid_fresh();
    if (b < 64) {
        scan_prompt(p, layer, lds, tid_fresh(), b);
    } else {
        phase_chunk(p, layer, smem, 64, (int)gridDim.x - 64);
        const int tid = tid_fresh(), wid = tid >> 6, lane = tid & 63;
        unsigned* readyc = (unsigned*)(ws_fresh(p.ws) + OFF_FLAG) + layer * 528;
        for (int t = (b - 64) * 8 + wid; t < 512; t += (gridDim.x - 64) * 8) {
            const int sb = t >> 5, h = (t >> 3) & 3, s = t & 7;
            wait_count(readyc + 512 + sb, 4u);
            scan_task(p, layer, (512 + sb) * 4 + h, 1, p.state0 + ((size_t)(layer * 16 + sb) * 4 + h) * 16384,
                      p.out + O_STS + ((size_t)(layer * 16 + sb) * 4 + h) * 16384, s, lane);
        }
    }
}

DI void phase_out(const Params& p, int layer) {
    const int tid = tid_fresh(), wid = tid >> 6, lane = tid & 63, g = lane >> 4, n = lane & 15, bid = bid_fresh();
    const bf16_t* pz = (const bf16_t*)(ws_fresh(p.ws) + OFF_PZ);
    bf16_t* mixin = (bf16_t*)(p.out + O_Y);
    f32x4 gwv[8];
#pragma unroll
    for (int s = 0; s < 8; ++s) gwv[s] = *(const f32x4*)(p.gdn_nw + layer * 128 + s * 16 + 4 * g);
    for (int t = bid * 8 + wid; t < 4096 + 64; t += gridDim.x * 8) {
        int u, mt0; bool two;
        if (t < 4096) { u = t >> 1; mt0 = (t & 1) * 2; two = true; } else { u = 2048 + (t - 4096); mt0 = 0; two = false; }
        const int c = u >> 2, h = u & 3;
        int row0, nvalid;
        if (c < 512) { row0 = (c >> 8) * 16384 + (c & 255) * 64; nvalid = 64; } else { row0 = TP + (c - 512) * 16; nvalid = 16; }
        const unsigned char* frb = ws_fresh(p.ws) + OFF_FR + (size_t)u * FR_STRIDE;
        const u32x4* qgf = (const u32x4*)(frb + FR_QG) + lane;
        const u32x4* qkf = (const u32x4*)(frb + FR_QK) + lane;
        const unsigned char* svh = sv_home(p, u);
        const u32x4* sfr = (const u32x4*)svh + lane;
        const u32x4* vfr = (const u32x4*)(svh + 32768) + lane;
        u32x2 zv[2][8];
#pragma unroll
        for (int q = 0; q < 2; ++q) {
            const int r = (mt0 + q) * 16 + n;
            const size_t grow = (size_t)(row0 + ((r < nvalid && (q == 0 || two)) ? r : 0));
            const bf16_t* zr = pz + grow * 512 + h * 128 + 4 * g;
#pragma unroll
            for (int s = 0; s < 8; ++s) zv[q][s] = *(const u32x2*)(zr + s * 16);
        }
        bf16x8 qg[2][4], qk[2][2];
#pragma unroll
        for (int q = 0; q < 2; ++q) {
            const int mt = two ? mt0 + q : 0;
#pragma unroll
            for (int ks = 0; ks < 4; ++ks) qg[q][ks] = __builtin_bit_cast(bf16x8, qgf[(mt * 4 + ks) * 64]);
#pragma unroll
            for (int ks = 0; ks < 2; ++ks) qk[q][ks] = __builtin_bit_cast(bf16x8, qkf[(mt * 2 + ks) * 64]);
        }
        f32x4 o[2][8];
#pragma unroll
        for (int s = 0; s < 8; ++s) {
            bf16x8 sb[4], vb[2];
#pragma unroll
            for (int ks = 0; ks < 4; ++ks) sb[ks] = __builtin_bit_cast(bf16x8, sfr[(s * 4 + ks) * 64]);
#pragma unroll
            for (int ks = 0; ks < 2; ++ks) vb[ks] = __builtin_bit_cast(bf16x8, vfr[(s * 2 + ks) * 64]);
#pragma unroll
            for (int q = 0; q < 2; ++q) {
                f32x4 acc = {0.f, 0.f, 0.f, 0.f};
#pragma unroll
                for (int ks = 0; ks < 4; ++ks) acc = MFMA16(sb[ks], qg[q][ks], acc);
#pragma unroll
                for (int ks = 0; ks < 2; ++ks) acc = MFMA16(vb[ks], qk[q][ks], acc);
                o[q][s] = acc;
            }
        }
#pragma unroll
        for (int q = 0; q < 2; ++q) {
            float v = 0.f;
#pragma unroll
            for (int s = 0; s < 8; ++s) v += o[q][s][0] * o[q][s][0] + o[q][s][1] * o[q][s][1] + o[q][s][2] * o[q][s][2] + o[q][s][3] * o[q][s][3];
            v += __shfl_xor(v, 16); v += __shfl_xor(v, 32);
            const float rs = rsqrtf(v * (1.f / 128.f) + 1e-6f);
            const int r = (mt0 + q) * 16 + n;
            if (r < nvalid && (q == 0 || two)) {
                bf16_t* mr = mixin + (size_t)(row0 + r) * 1024 + h * 128 + 4 * g;
#pragma unroll
                for (int s = 0; s < 8; ++s) {
                    const float z0 = __uint_as_float(zv[q][s].x << 16), z1 = __uint_as_float(zv[q][s].x & 0xffff0000u), z2 = __uint_as_float(zv[q][s].y << 16), z3 = __uint_as_float(zv[q][s].y & 0xffff0000u);
                    const f32x4 ov = o[q][s] * rs * gwv[s];
                    u32x2 w; w.x = pk_bf16(ov[0] * silu_fast(z0), ov[1] * silu_fast(z1)); w.y = pk_bf16(ov[2] * silu_fast(z2), ov[3] * silu_fast(z3));
                    *(u32x2*)(mr + s * 16) = w;
                }
            }
        }
    }
}

#define XB_TMO      128
#define XB_XCNT(j)  (256  + 64 * (j))
#define XB_XSUB(j)  (1280 + 64 * (j))
#define XB_XGEN(j)  (2304 + 64 * (j))
#define XB_TOP      3328
#define XB_TOPGEN   3392
#define XCD_BAR_WORDS 3456
#define XB_SPIN_CAP (1u << 20)
DI unsigned xb_ld(unsigned* p)              { return __hip_atomic_load(p, __ATOMIC_RELAXED, __HIP_MEMORY_SCOPE_AGENT); }
DI unsigned xb_add(unsigned* p, unsigned v) { return __hip_atomic_fetch_add(p, v, __ATOMIC_RELAXED, __HIP_MEMORY_SCOPE_AGENT); }
DI unsigned xb_xcc_id() { return (unsigned)__builtin_amdgcn_s_getreg((3 << 11) | 20) & 0xFu; }
#define XB_SPIN(cond, bar) do { unsigned _sp = 0; while (cond) { __builtin_amdgcn_s_sleep(1); \
    if ((++_sp & 255u) == 0u) { if (xb_ld(&(bar)[XB_TMO])) break; if (_sp > XB_SPIN_CAP) { atomicAdd(&(bar)[XB_TMO], 1u); break; } } } } while (0)
struct XcdBarrier { unsigned* bar; unsigned x; volatile LAS unsigned* st; };
DI XcdBarrier xcd_barrier_post(unsigned* bar, volatile LAS unsigned* st) {
    XcdBarrier b; b.bar = bar; b.x = xb_xcc_id(); b.st = st;
    if (threadIdx.x == 0) (void)xb_add(&bar[XB_XCNT(b.x)], 1u);
    return b;
}
DI void xcd_barrier_complete(unsigned* bar, unsigned x, unsigned& nloc, unsigned& nx) {
    const unsigned G = gridDim.x * gridDim.y * gridDim.z;
    unsigned sum, cnt, mine, sp = 0u;
    for (;;) {
        sum = 0u; cnt = 0u; mine = 0u;
#pragma unroll
        for (unsigned j = 0; j < 16; ++j) { const unsigned c = xb_ld(&bar[XB_XCNT(j)]); sum += c; cnt += (c > 0u) ? 1u : 0u; mine = (j == x) ? c : mine; }
        if (sum == G) break;
        __builtin_amdgcn_s_sleep(1);
        if ((++sp & 255u) == 0u) { if (xb_ld(&bar[XB_TMO])) break; if (sp > XB_SPIN_CAP) { atomicAdd(&bar[XB_TMO], 1u); break; } }
    }
    nloc = mine > 0u ? mine : 1u; nx = cnt > 0u ? cnt : 1u;
}
DI void xcd_barrier(const XcdBarrier& b) {
    asm volatile("s_waitcnt vmcnt(0)" ::: "memory");
    __syncthreads();
    if (threadIdx.x == 0) {
        unsigned* bar = b.bar;
        asm volatile("" : "+s"(bar));
        __builtin_amdgcn_s_waitcnt(0);
        unsigned nloc = b.st[0], nx = b.st[1];
        if (nloc == 0u) { xcd_barrier_complete(bar, b.x, nloc, nx); b.st[0] = nloc; b.st[1] = nx; }
        const unsigned old = xb_add(&bar[XB_XSUB(b.x)], 1u);
        const unsigned gen = old / nloc;
        if (old + 1u == (gen + 1u) * nloc) {
            __builtin_amdgcn_fence(__ATOMIC_RELEASE, "agent");
            asm volatile("s_waitcnt vmcnt(0)" ::: "memory");
            const unsigned og = xb_add(&bar[XB_TOP], 1u);
            const unsigned tg = og / nx;
            if (og + 1u == (tg + 1u) * nx) xb_add(&bar[XB_TOPGEN], 1u);
            else XB_SPIN(xb_ld(&bar[XB_TOPGEN]) == tg, bar);
            __builtin_amdgcn_fence(__ATOMIC_ACQUIRE, "agent");
            xb_add(&bar[XB_XGEN(b.x)], 1u);
            asm volatile("s_waitcnt vmcnt(0)" ::: "memory");
        } else {
            XB_SPIN(xb_ld(&bar[XB_XGEN(b.x)]) == gen, bar);
            __builtin_amdgcn_fence(__ATOMIC_ACQUIRE, "agent");
            asm volatile("s_waitcnt vmcnt(0)" ::: "memory");
        }
    }
    __syncthreads();
}

__global__ void __launch_bounds__(512) mega(Params p) {
    extern __shared__ __attribute__((aligned(16))) unsigned char smem[];
    cg::grid_group grid = cg::this_grid();
    LAS unsigned char* lds = (LAS unsigned char*)smem;
    volatile LAS unsigned* xst = (volatile LAS unsigned*)(lds + LDS_BYTES - 16);
    if (threadIdx.x == 0) { xst[0] = 0u; xst[1] = 0u; }
    __syncthreads();
    const XcdBarrier xb = xcd_barrier_post((unsigned*)(ws_fresh(p.ws) + OFF_BAR), xst);

    phase_weights(p, smem);
    row_phase<0>(p, 0, 0, smem);
    if (p.ws == nullptr) grid.sync();
    xcd_barrier(xb);
    for (int l = 0; l < 2; ++l) {
        {
            pg8::Gemm g{(const bf16_t*)(ws_fresh(p.ws) + OFF_XB), (const bf16_t*)(ws_fresh(p.ws) + OFF_WIN + l * SZ_WIN), TT, 3584, 1024};
            pg8::StaticOrder S; S.init(TT, 3584, 1024, gridDim.x, bid_fresh());
            EpiG1 e{(const float*)(ws_fresh(p.ws) + OFF_RSTD), (bf16_t*)(ws_fresh(p.ws) + OFF_PQKV), (bf16_t*)(ws_fresh(p.ws) + OFF_PSC), (bf16_t*)(ws_fresh(p.ws) + OFF_PZ)};
            pg8::gemm_phase(lds, g, S, e);
        }
        xcd_barrier(xb);
        phase_chunk_scan(p, l, smem, lds);
        xcd_barrier(xb);
        phase_out(p, l);
        xcd_barrier(xb);
        {
            pg8::Gemm g{(const bf16_t*)(p.out + O_Y), (const bf16_t*)(ws_fresh(p.ws) + OFF_WO + l * SZ_WO), TT, 1024, 1024};
            pg8::SplitOrder S; S.init(1024, 1024, gridDim.x, bid_fresh());
            EpiRawSplit e{(bf16_t*)(ws_fresh(p.ws) + OFF_RAW), (float*)(ws_fresh(p.ws) + OFF_PZ)};
            pg8::gemm_phase(lds, g, S, e);
        }
        xcd_barrier(xb);
        row_phase<1>(p, l, 0, smem);
        xcd_barrier(xb);
        {
            pg8::Gemm g{(const bf16_t*)(ws_fresh(p.ws) + OFF_XB), (const bf16_t*)(ws_fresh(p.ws) + OFF_WGU + l * SZ_WGU), TT, 5632, 1024};
            pg8::StaticOrder S; S.init(TT, 5632, 1024, gridDim.x, bid_fresh());
            EpiGU e{(const float*)(ws_fresh(p.ws) + OFF_RSTD), (bf16_t*)(ws_fresh(p.ws) + OFF_ACT)};
            pg8::gemm_phase(lds, g, S, e);
        }
        xcd_barrier(xb);
        {
            pg8::Gemm g{(const bf16_t*)(ws_fresh(p.ws) + OFF_ACT), (const bf16_t*)(ws_fresh(p.ws) + OFF_WD + l * SZ_WD), TT, 1024, DFF};
            pg8::SplitOrder S; S.init(1024, DFF, gridDim.x, bid_fresh());
            EpiRawSplit e{(bf16_t*)(ws_fresh(p.ws) + OFF_RAW), (float*)(ws_fresh(p.ws) + OFF_PZ)};
            pg8::gemm_phase(lds, g, S, e);
        }
        xcd_barrier(xb);
        if (l == 0) { row_phase<2>(p, 0, 1, smem); xcd_barrier(xb); }
        else row_phase<3>(p, 1, 0, smem);
    }
}

extern "C" void kernel_launch(void* const* d_in, const int* in_sizes, int n_in, void* d_out, int out_size, void* d_ws, size_t ws_size,
                              hipStream_t stream) {
    static int grid_blocks = 0;
    if (!grid_blocks) {
        int dev = 0, cus = 0, per_cu = 0;
        hipGetDevice(&dev);
        hipDeviceGetAttribute(&cus, hipDeviceAttributeMultiprocessorCount, dev);
        hipFuncSetAttribute((const void*)mega, hipFuncAttributeMaxDynamicSharedMemorySize, LDS_BYTES);
        hipOccupancyMaxActiveBlocksPerMultiprocessor(&per_cu, mega, 512, LDS_BYTES);
        if (per_cu > 1) per_cu = 1;
        grid_blocks = cus * per_cu;
        if (grid_blocks < 128) { fprintf(stderr, "unexpected occupancy: cus=%d per_cu=%d\n", cus, per_cu); }
    }
    if (ws_size < WS_NEED) { fprintf(stderr, "workspace too small: %zu < %zu\n", ws_size, (size_t)WS_NEED); return; }
    Params p{};
    const float* const* in = (const float* const*)d_in;
    p.xp = in[0]; p.xs = in[1]; p.cache_conv = in[2]; p.state0 = in[3]; p.cache_sc = in[4]; p.n_mix_pre = in[5]; p.w_in = in[6];
    p.conv_w = in[7]; p.a_log = in[8]; p.dt_bias = in[9]; p.gdn_nw = in[10]; p.conv_sc_w = in[11]; p.w_o = in[12]; p.n_mix_post = in[13];
    p.n_ffn_pre = in[14]; p.w_gate = in[15]; p.w_up = in[16]; p.w_down = in[17]; p.n_ffn_post = in[18];
    p.out = (float*)d_out; p.ws = (unsigned char*)d_ws;
    hipMemsetAsync((unsigned char*)d_ws + OFF_BAR, 0, 32768, stream);
    void* args[] = {&p};
    hipError_t e = hipLaunchCooperativeKernel((const void*)mega, dim3(grid_blocks), dim3(512), args, LDS_BYTES, stream);
    if (e != hipSuccess) fprintf(stderr, "cooperative launch failed: %s (grid %d)\n", hipGetErrorString(e), grid_blocks);
}
```

```cpp
#include <hip/hip_runtime.h>
#include <hip/hip_cooperative_groups.h>
#include <cstdio>
namespace cg = cooperative_groups;

#define LAS __attribute__((address_space(3)))
typedef unsigned short bf16_t;
typedef short bf16x8 __attribute__((ext_vector_type(8)));
typedef float f32x4 __attribute__((ext_vector_type(4)));
typedef float f32x2 __attribute__((ext_vector_type(2)));
typedef unsigned u32x4 __attribute__((ext_vector_type(4)));
typedef unsigned u32x2 __attribute__((ext_vector_type(2)));
typedef __bf16 bf16v2 __attribute__((ext_vector_type(2)));
#define DI __device__ __forceinline__
DI int tid_fresh() { int t = threadIdx.x; asm volatile("" : "+v"(t)); return t; }
DI int bid_fresh() { int b = blockIdx.x; asm volatile("" : "+s"(b)); return b; }
DI unsigned char* ws_fresh(unsigned char* w) { asm volatile("" : "+s"(w)); return w; }

constexpr int DM = 1024, TT = 33024, TP = 32768, DFF = 2816, INDIM = 3592;
constexpr int NCHH = 2112;
constexpr int LDS_BYTES = 147456;

constexpr size_t SZ_WIN = (size_t)3584 * 1024 * 2, SZ_WO = (size_t)1024 * 1024 * 2, SZ_WGU = (size_t)5632 * 1024 * 2, SZ_WD = (size_t)1024 * 2816 * 2;
constexpr size_t OFF_WIN = 0;
constexpr size_t OFF_WO = OFF_WIN + 2 * SZ_WIN;
constexpr size_t OFF_WGU = OFF_WO + 2 * SZ_WO;
constexpr size_t OFF_WD = OFF_WGU + 2 * SZ_WGU;
constexpr size_t OFF_WBA = OFF_WD + 2 * SZ_WD;
constexpr size_t OFF_RSTD = OFF_WBA + 2 * 8 * 1024 * 4;
constexpr size_t OFF_BETA = OFF_RSTD + (size_t)TT * 4;
constexpr size_t OFF_GLOG = OFF_BETA + (size_t)TT * 16;
constexpr size_t OFF_AL = OFF_GLOG + (size_t)TT * 16;
constexpr size_t OFF_BAR = OFF_AL + 16384;
constexpr size_t OFF_FLAG = OFF_BAR + 16384;
constexpr size_t OFF_SPARE = OFF_FLAG + 16384;
constexpr size_t OFF_XB = OFF_SPARE + (size_t)18 * 196608;
constexpr size_t OFF_PQKV = OFF_XB + (size_t)TT * 1024 * 2;
constexpr size_t OFF_PSC = OFF_PQKV + (size_t)TT * 1536 * 2;
constexpr size_t OFF_PZ = OFF_PSC + (size_t)TT * 1536 * 2;
constexpr size_t OFF_ACT = OFF_PQKV;
constexpr size_t OFF_FR = OFF_PZ + (size_t)TT * 512 * 2;
constexpr size_t FR_STRIDE = 74752, FR_W = 0, FR_KT = 16384, FR_QG = 32768, FR_QK = 49152, FR_U = 57344, FR_META = 73728;
constexpr size_t OFF_RAW = OFF_FR;
constexpr size_t WS_NEED = OFF_FR + (size_t)NCHH * FR_STRIDE;
static_assert((size_t)TT * 1024 * 4 <= (size_t)NCHH * FR_STRIDE, "raw fits");
static_assert(WS_NEED <= (size_t)536870912, "workspace");

constexpr size_t O_Y = 0;
constexpr size_t O_CONVP = (size_t)TT * 1024;
constexpr size_t O_STP = O_CONVP + 2 * 2 * 3 * 1536;
constexpr size_t O_SCP = O_STP + (size_t)2 * 2 * 4 * 16384;
constexpr size_t O_CONVS = O_SCP + 2 * 2 * 2 * 512;
constexpr size_t O_STS = O_CONVS + (size_t)2 * 16 * 3 * 1536;
constexpr size_t O_SCS = O_STS + (size_t)2 * 16 * 4 * 16384;

struct Params {
    const float *xp, *xs, *cache_conv, *state0, *cache_sc, *n_mix_pre, *w_in, *conv_w, *a_log, *dt_bias, *gdn_nw, *conv_sc_w, *w_o,
        *n_mix_post, *n_ffn_pre, *w_gate, *w_up, *w_down, *n_ffn_post;
    float* out;
    unsigned char* ws;
};

DI float bf2f(bf16_t v) { return __uint_as_float(((unsigned)v) << 16); }
DI unsigned pk_bf16(float lo, float hi) {
    f32x2 v = {lo, hi};
    bf16v2 r = __builtin_convertvector(v, bf16v2);
    return __builtin_bit_cast(unsigned, r);
}
DI bf16_t f2bf(float x) { return (bf16_t)(pk_bf16(x, 0.f) & 0xffffu); }
DI float silu_f(float x) { return x / (1.f + __expf(-x)); }
DI float wave_sum(float v) {
    v += __builtin_bit_cast(float, __builtin_amdgcn_update_dpp(0, __builtin_bit_cast(int, v), 0xB1, 0xf, 0xf, true));
    v += __builtin_bit_cast(float, __builtin_amdgcn_update_dpp(0, __builtin_bit_cast(int, v), 0x4E, 0xf, 0xf, true));
    v += __builtin_bit_cast(float, __builtin_amdgcn_update_dpp(0, __builtin_bit_cast(int, v), 0x141, 0xf, 0xf, true));
    v += __builtin_bit_cast(float, __builtin_amdgcn_update_dpp(0, __builtin_bit_cast(int, v), 0x140, 0xf, 0xf, true));
    v += __builtin_bit_cast(float, __builtin_amdgcn_update_dpp(0, __builtin_bit_cast(int, v), 0x142, 0xa, 0xf, false));
    v += __builtin_bit_cast(float, __builtin_amdgcn_update_dpp(0, __builtin_bit_cast(int, v), 0x143, 0xc, 0xf, false));
    return __builtin_bit_cast(float, __builtin_amdgcn_readlane(__builtin_bit_cast(int, v), 63));
}
DI bf16x8 pack8(const f32x4& a, const f32x4& b) {
    u32x4 p; p.x = pk_bf16(a[0], a[1]); p.y = pk_bf16(a[2], a[3]); p.z = pk_bf16(b[0], b[1]); p.w = pk_bf16(b[2], b[3]);
    return __builtin_bit_cast(bf16x8, p);
}

DI unsigned char* sv_home(const Params& p, int u) {
    const int c = u >> 2, h = u & 3;
    if (c < 512) {
        const int n = c & 255, b = c >> 8;
        if (n > 0) return ws_fresh(p.ws) + OFF_PQKV + (size_t)(b * 16384 + (n - 1) * 64) * 3072 + (size_t)h * 49152;
        return ws_fresh(p.ws) + OFF_SPARE + (size_t)b * 196608 + (size_t)h * 49152;
    }
    return ws_fresh(p.ws) + OFF_SPARE + (size_t)(2 + c - 512) * 196608 + (size_t)h * 49152;
}
DI void wait_count(unsigned* f, unsigned need) {
    unsigned sp = 0;
    while (__hip_atomic_load(f, __ATOMIC_RELAXED, __HIP_MEMORY_SCOPE_AGENT) < need) { __builtin_amdgcn_s_sleep(2); if (++sp > (1u << 22)) break; }
    __builtin_amdgcn_fence(__ATOMIC_ACQUIRE, "agent");
    asm volatile("s_waitcnt vmcnt(0)" ::: "memory");
}
DI void wait_counts8(unsigned* f, int first, int last_valid, int lane, unsigned need) {
    int idx = first + (lane & 7); if (idx > last_valid) idx = last_valid;
    unsigned sp = 0;
    for (;;) {
        const unsigned v = __hip_atomic_load(f + idx, __ATOMIC_RELAXED, __HIP_MEMORY_SCOPE_AGENT);
        if (__all(v >= need)) break;
        __builtin_amdgcn_s_sleep(2);
        if (++sp > (1u << 22)) break;
    }
    __builtin_amdgcn_fence(__ATOMIC_ACQUIRE, "agent");
    asm volatile("s_waitcnt vmcnt(0)" ::: "memory");
}
#define MFMA16(a, b, c) __builtin_amdgcn_mfma_f32_16x16x32_bf16((a), (b), (c), 0, 0, 0)

namespace pg8 {
constexpr int BM = 256, BK = 64, HALF = 128, HTB = HALF * BK * 2, STAGE_BYTES = 8 * HTB, NXCD = 8, WGM = 8;
DI int lds_byte(int r, int c) { const int st = (r >> 4) * 2 + (c >> 5), rr = r & 15, cc = c & 31, ob = rr * 64 + cc * 2; return st * 1024 + (ob ^ (((ob >> 9) & 1) << 5)); }
DI void stage_rc(int b, int& R, int& C) { const int st = b / 1024, sb = b % 1024, swz = sb ^ (((sb >> 9) & 1) << 5); R = (st >> 1) * 16 + swz / 64; C = (st & 1) * 32 + (swz % 64) / 2; }
DI int perm32(int rho) { const int n = rho >> 4, i = rho & 15; return 8 * (i >> 2) + 4 * n + (i & 3); }
struct Unit { int pm, pn, nt; unsigned kofs; };
struct Gemm { const bf16_t* A; const bf16_t* Bt; int M, N, K; };
struct StaticOrder {
    int nM, nN, nwg, G, c, ntf;
    DI void init(int M, int N, int K, int G_, int c_) { nM = M / BM; nN = N / BM; nwg = nM * nN; G = G_; c = c_; ntf = K / BK; }
    DI void map(int wgid, Unit& u) const {
        { const int q = nwg / NXCD, r = nwg % NXCD, xcd = wgid % NXCD, off = wgid / NXCD; wgid = (xcd < r ? xcd * (q + 1) : r * (q + 1) + (xcd - r) * q) + off; }
        const int nig = WGM * nN, gid = wgid / nig, fm = gid * WGM, gsz = (nM - fm) < WGM ? (nM - fm) : WGM;
        u.pm = fm + ((wgid % nig) % gsz); u.pn = (wgid % nig) / gsz; u.nt = ntf; u.kofs = 0u;
    }
    DI bool next(int i, Unit& u) const {
        const long L = (long)i * G + c; if (L >= nwg) return false;
        map((int)L, u); return true;
    }
};
struct SplitOrder : StaticOrder {
    int nsub;
    DI void init(int N, int K, int G_, int c_) { StaticOrder::init(TP, N, K, G_, c_); nsub = nN * (K / 256); }
    DI bool next(int i, Unit& u) const {
        const long L = (long)i * G + c;
        if (L < nwg) { map((int)L, u); return true; }
        const int j = (int)(L - nwg); if (j >= nsub) return false;
        u.pm = 128; u.pn = j % nN; u.nt = 4; u.kofs = (unsigned)(j / nN) * 512u; return true;
    }
};
template <class Epi, class Sched, bool ALIGN_EPI = true>
DI void gemm_phase(LAS unsigned char* lds, const Gemm g, const Sched& S, const Epi& E) {
    const int tid = tid_fresh(), wid = __builtin_amdgcn_readfirstlane(tid >> 6), lane = tid & 63, wr = wid >> 2, wc = wid & 3, fr = lane & 15, fq = lane >> 4;
    const int K = g.K;
    unsigned voffA[2], voffB[2];
#pragma unroll
    for (int i = 0; i < 2; ++i) { int R, C; stage_rc(tid * 16 + i * 8192, R, C); const int Rb = ((R & ~31) + perm32(R & 31));
        voffA[i] = (unsigned)(R * K + C) * 2u; voffB[i] = (unsigned)(Rb * K + C) * 2u; }
    const size_t kstep = (size_t)(BK * 2);
    const size_t hstep = (size_t)HALF * K * 2;
    const size_t tstep = 2 * hstep;
    const unsigned ldsw = (unsigned)wid * 1024u;
    const int aoff = lds_byte(wr * 64 + fr, fq * 8), boff = lds_byte(wc * 32 + fr, fq * 8);
#define PG8_SA(b, h) (((b) * 2 + (h)) * HTB)
#define PG8_SB(b, h) ((4 + (b) * 2 + (h)) * HTB)
#define PG8_STAGE(bufoff, gbase, voff) do { _Pragma("unroll") for (int _i = 0; _i < 2; ++_i) \
        __builtin_amdgcn_global_load_lds((const unsigned*)((const char*)(gbase) + (voff)[_i]), (LAS unsigned*)(lds + (bufoff) + ldsw + _i * 8192), 16, 0, 0); } while (0)
#define PG8_LDA(dst, b, h) do { _Pragma("unroll") for (int m = 0; m < 4; ++m) _Pragma("unroll") for (int k = 0; k < 2; ++k) dst[m][k] = *(const LAS bf16x8*)(lds + PG8_SA(b, h) + aoff + m * 2048 + k * 1024); } while (0)
#define PG8_LDB(dst, b, h) do { _Pragma("unroll") for (int n = 0; n < 2; ++n) _Pragma("unroll") for (int k = 0; k < 2; ++k) dst[n][k] = *(const LAS bf16x8*)(lds + PG8_SB(b, h) + boff + n * 2048 + k * 1024); } while (0)
#define PG8_MMA(ai, bj, At, Bt) do { __builtin_amdgcn_s_setprio(1); _Pragma("unroll") for (int m = 0; m < 4; ++m) _Pragma("unroll") for (int n = 0; n < 2; ++n) _Pragma("unroll") for (int k = 0; k < 2; ++k) \
        acc[ai][bj][m][n] = __builtin_amdgcn_mfma_f32_16x16x32_bf16(Bt[n][k], At[m][k], acc[ai][bj][m][n], 0, 0, 0); __builtin_amdgcn_s_setprio(0); } while (0)
#define PG8_WAIT_V(n) asm volatile("s_waitcnt vmcnt(" #n ")" ::: "memory")
#define PG8_WAIT_L(n) asm volatile("s_waitcnt lgkmcnt(" #n ")" ::: "memory")
#define PG8_BAR __builtin_amdgcn_s_barrier()
#define PG8_SCHED __builtin_amdgcn_sched_barrier(0)
    Unit cur, nxt; int ui = 0;
    if (!S.next(0, cur)) return;
    f32x4 acc[2][2][4][2];
#pragma unroll
    for (int a = 0; a < 2; ++a)
#pragma unroll
        for (int b = 0; b < 2; ++b)
#pragma unroll
            for (int m = 0; m < 4; ++m)
#pragma unroll
                for (int n = 0; n < 2; ++n) acc[a][b][m][n] = (f32x4){0.f, 0.f, 0.f, 0.f};
    bf16x8 At[4][2], B0[2][2], B1[2][2];
    const char* cA = (const char*)g.A + (size_t)cur.pm * tstep + cur.kofs; const char* cB = (const char*)g.Bt + (size_t)cur.pn * tstep + cur.kofs;
    PG8_STAGE(PG8_SB(0, 0), cB, voffB); PG8_STAGE(PG8_SB(0, 1), cB + hstep, voffB); PG8_STAGE(PG8_SA(0, 0), cA, voffA); PG8_STAGE(PG8_SA(0, 1), cA + hstep, voffA);
    if (wr == 1) PG8_BAR;
    PG8_WAIT_V(2); PG8_BAR;
    PG8_STAGE(PG8_SB(1, 0), cB + kstep, voffB); PG8_STAGE(PG8_SA(1, 0), cA + kstep, voffA); PG8_STAGE(PG8_SB(1, 1), cB + hstep + kstep, voffB);
    PG8_WAIT_V(6); PG8_BAR;
    for (;;) {
        const bool has_next = S.next(ui + 1, nxt);
        const char* nA = has_next ? (const char*)g.A + (size_t)nxt.pm * tstep + nxt.kofs : cA; const char* nB = has_next ? (const char*)g.Bt + (size_t)nxt.pn * tstep + nxt.kofs : cB;
        const int nt = cur.nt;
        for (int t = 0; t < nt; t += 2) {
            const bool last = (t == nt - 2);
            const char* a1 = cA + (size_t)(t + 1) * kstep;
            const char* a2 = last ? nA : cA + (size_t)(t + 2) * kstep; const char* b2 = last ? nB : cB + (size_t)(t + 2) * kstep;
            const char* a3 = a2 + kstep; const char* b3 = b2 + kstep;
            PG8_LDB(B0, 0, 0); PG8_LDB(B1, 0, 1); PG8_SCHED; PG8_LDA(At, 0, 0); PG8_STAGE(PG8_SA(1, 1), a1 + hstep, voffA);
            PG8_WAIT_V(8); PG8_WAIT_L(0); PG8_BAR; PG8_MMA(0, 0, At, B0); PG8_MMA(0, 1, At, B1); PG8_BAR; PG8_SCHED;
            PG8_LDA(At, 0, 1); PG8_STAGE(PG8_SB(0, 0), b2, voffB); PG8_STAGE(PG8_SB(0, 1), b2 + hstep, voffB); PG8_STAGE(PG8_SA(0, 0), a2, voffA);
            PG8_WAIT_V(8); PG8_WAIT_L(0); PG8_BAR; PG8_MMA(1, 0, At, B0); PG8_MMA(1, 1, At, B1); PG8_BAR; PG8_SCHED;
            PG8_LDB(B0, 1, 0); PG8_LDB(B1, 1, 1); PG8_SCHED; PG8_LDA(At, 1, 0); PG8_STAGE(PG8_SA(0, 1), a2 + hstep, voffA);
            PG8_WAIT_V(8); PG8_WAIT_L(0); PG8_BAR; PG8_MMA(0, 0, At, B0); PG8_MMA(0, 1, At, B1); PG8_BAR; PG8_SCHED;
            PG8_LDA(At, 1, 1); PG8_STAGE(PG8_SB(1, 0), b3, voffB); PG8_STAGE(PG8_SB(1, 1), b3 + hstep, voffB); PG8_STAGE(PG8_SA(1, 0), a3, voffA);
            PG8_WAIT_V(8); PG8_WAIT_L(0); PG8_BAR; PG8_MMA(1, 0, At, B0); PG8_MMA(1, 1, At, B1); PG8_BAR; PG8_SCHED;
        }
        if constexpr (ALIGN_EPI) { if (wr == 0) PG8_BAR; }
        E(acc, cur, wr, wc, fr, fq);
        if (!has_next) break;
#pragma unroll
        for (int a = 0; a < 2; ++a)
#pragma unroll
            for (int b = 0; b < 2; ++b)
#pragma unroll
                for (int m = 0; m < 4; ++m)
#pragma unroll
                    for (int n = 0; n < 2; ++n) acc[a][b][m][n] = (f32x4){0.f, 0.f, 0.f, 0.f};
        cur = nxt; cA = nA; cB = nB; ++ui;
        if constexpr (ALIGN_EPI) { if (wr == 1) PG8_BAR; }
    }
    PG8_WAIT_V(0);
    if constexpr (!ALIGN_EPI) { if (wr == 0) PG8_BAR; }
    PG8_BAR;
#undef PG8_SA
#undef PG8_SB
#undef PG8_STAGE
#undef PG8_LDA
#undef PG8_LDB
#undef PG8_MMA
#undef PG8_WAIT_V
#undef PG8_WAIT_L
#undef PG8_BAR
#undef PG8_SCHED
}
}

using pg8::Unit;
typedef f32x4 AccT[2][2][4][2];

struct EpiG1 {
    const float* rstd; bf16_t *pqkv, *psc, *pz;
    DI void operator()(const AccT& acc, const Unit& u, int wr, int wc, int fr, int fq) const {
        bf16_t* base; int ldc, colt;
        if (u.pn < 6) { base = pqkv; ldc = 1536; colt = u.pn * 256; }
        else if (u.pn < 8) { base = pz; ldc = 512; colt = (u.pn - 6) * 256; }
        else { base = psc; ldc = 1536; colt = (u.pn - 8) * 256; }
        const int row0 = u.pm * 256 + wr * 64 + fr, col0 = colt + wc * 32 + 8 * fq;
#pragma unroll
        for (int ai = 0; ai < 2; ++ai)
#pragma unroll
            for (int m = 0; m < 4; ++m) {
                const int row = row0 + ai * 128 + m * 16;
                bf16_t* rowp = base + (size_t)row * ldc + col0;
#pragma unroll
                for (int bj = 0; bj < 2; ++bj) {
                    const f32x4 v0 = acc[ai][bj][m][0], v1 = acc[ai][bj][m][1];
                    u32x4 w; w.x = pk_bf16(v0[0], v0[1]); w.y = pk_bf16(v0[2], v0[3]); w.z = pk_bf16(v1[0], v1[1]); w.w = pk_bf16(v1[2], v1[3]);
                    *(u32x4*)(rowp + bj * 128) = w;
                }
            }
    }
};
struct EpiRawSplit {
    bf16_t* C; float* racc;
    DI void operator()(const AccT& acc, const Unit& u, int wr, int wc, int fr, int fq) const {
        const int row0 = u.pm * 256 + wr * 64 + fr, col0 = u.pn * 256 + wc * 32 + 8 * fq;
        if (u.pm < 128) {
#pragma unroll
            for (int ai = 0; ai < 2; ++ai)
#pragma unroll
                for (int m = 0; m < 4; ++m) {
                    bf16_t* rowp = C + (size_t)(row0 + ai * 128 + m * 16) * 1024 + col0;
#pragma unroll
                    for (int bj = 0; bj < 2; ++bj) {
                        const f32x4 v0 = acc[ai][bj][m][0], v1 = acc[ai][bj][m][1];
                        u32x4 w; w.x = pk_bf16(v0[0], v0[1]); w.y = pk_bf16(v0[2], v0[3]); w.z = pk_bf16(v1[0], v1[1]); w.w = pk_bf16(v1[2], v1[3]);
                        *(u32x4*)(rowp + bj * 128) = w;
                    }
                }
        } else {
#pragma unroll
            for (int ai = 0; ai < 2; ++ai)
#pragma unroll
                for (int m = 0; m < 4; ++m) {
                    float* rowp = racc + (size_t)(u.kofs >> 9) * 262144 + (size_t)(row0 - TP + ai * 128 + m * 16) * 1024 + col0;
#pragma unroll
                    for (int bj = 0; bj < 2; ++bj) { *(f32x4*)(rowp + bj * 128) = acc[ai][bj][m][0]; *(f32x4*)(rowp + bj * 128 + 4) = acc[ai][bj][m][1]; }
                }
        }
    }
};
struct EpiGU {
    const float* rstd; bf16_t* act;
    DI void operator()(const AccT& acc, const Unit& u, int wr, int wc, int fr, int fq) const {
        const int row0 = u.pm * 256 + wr * 64 + fr, col0 = u.pn * 128 + wc * 32 + 8 * fq;
#pragma unroll
        for (int ai = 0; ai < 2; ++ai)
#pragma unroll
            for (int m = 0; m < 4; ++m) {
                const int row = row0 + ai * 128 + m * 16;
                float o[8];
#pragma unroll
                for (int n = 0; n < 2; ++n)
#pragma unroll
                    for (int i = 0; i < 4; ++i) { const float gv = acc[ai][0][m][n][i], uv = acc[ai][1][m][n][i]; o[n * 4 + i] = gv * __builtin_amdgcn_rcpf(1.f + __expf(-gv)) * uv; }
                u32x4 w; w.x = pk_bf16(o[0], o[1]); w.y = pk_bf16(o[2], o[3]); w.z = pk_bf16(o[4], o[5]); w.w = pk_bf16(o[6], o[7]);
                *(u32x4*)(act + (size_t)row * DFF + col0) = w;
            }
    }
};

DI void wtile(const float* src, int ld, int k0, int n0, const float* gain, bf16_t* dst, int K, int nd0, unsigned char* smem) {
    bf16_t* tl = (bf16_t*)smem;
    const int tid = tid_fresh();
    {
        const int kk = tid >> 2, cs = (tid & 3) * 16;
        const float gsc = gain ? gain[k0 + kk] : 1.f;
        const float* sp = src + (size_t)(k0 + kk) * ld + n0 + cs;
        f32x4 v[4];
#pragma unroll
        for (int q = 0; q < 4; ++q) v[q] = *(const f32x4*)(sp + 4 * q);
#pragma unroll
        for (int q = 0; q < 4; ++q)
#pragma unroll
            for (int i = 0; i < 4; ++i) tl[(cs + 4 * q + i) * 136 + kk] = f2bf(v[q][i] * gsc);
    }
    __syncthreads();
    {
        const int n = tid >> 3, ks = (tid & 7) * 16;
        const u32x4 v0 = *(const u32x4*)(tl + n * 136 + ks), v1 = *(const u32x4*)(tl + n * 136 + ks + 8);
        bf16_t* dp = dst + (size_t)(nd0 + n) * K + k0 + ks;
        *(u32x4*)dp = v0; *(u32x4*)(dp + 8) = v1;
    }
    __syncthreads();
}
DI void phase_weights(const Params& p, unsigned char* smem) {
    constexpr int PER = 448 + 128 + 704 + 352;
    const int bid = bid_fresh();
    for (int j = bid; j < 2 * PER; j += gridDim.x) {
        const int l = j / PER; int r = j % PER;
        if (r < 448) {
            const int kt = r / 56, nt = r % 56, nd0 = nt * 64, n0 = nd0 < 2048 ? nd0 : nd0 + 8;
            wtile(p.w_in + (size_t)l * 1024 * INDIM, INDIM, kt * 128, n0, p.n_mix_pre + l * 1024, (bf16_t*)(ws_fresh(p.ws) + OFF_WIN + l * SZ_WIN), 1024, nd0, smem);
        } else if (r < 448 + 128) {
            r -= 448; const int kt = r / 16, nt = r % 16;
            wtile(p.w_o + (size_t)l * 1024 * 1024, 1024, kt * 128, nt * 64, nullptr, (bf16_t*)(ws_fresh(p.ws) + OFF_WO + l * SZ_WO), 1024, nt * 64, smem);
        } else if (r < 448 + 128 + 704) {
            r -= 448 + 128; const int kt = r / 88, nt = r % 88, nd0 = nt * 64, pp = nd0 / 256, s = (nd0 % 256) / 128, jj = nd0 % 128;
            const float* src = (s ? p.w_up : p.w_gate) + (size_t)l * 1024 * DFF;
            wtile(src, DFF, kt * 128, pp * 128 + jj, p.n_ffn_pre + l * 1024, (bf16_t*)(ws_fresh(p.ws) + OFF_WGU + l * SZ_WGU), 1024, nd0, smem);
        } else {
            r -= 448 + 128 + 704; const int kt = r / 16, nt = r % 16;
            wtile(p.w_down + (size_t)l * DFF * 1024, 1024, kt * 128, nt * 64, nullptr, (bf16_t*)(ws_fresh(p.ws) + OFF_WD + l * SZ_WD), DFF, nt * 64, smem);
        }
    }
}

template <int MODE>
DI void row_phase(const Params& p, int layer, int lnext, unsigned char* smem) {
    const int tid = tid_fresh(), wid = tid >> 6, lane = tid & 63, bid = bid_fresh();
    float* wl = (float*)smem;
    if (MODE == 0 || MODE == 2) {
        for (int i = tid; i < 8192; i += 512) {
            const int k = i >> 3, j = i & 7;
            wl[j * 1024 + k] = p.n_mix_pre[lnext * 1024 + k] * p.w_in[((size_t)lnext * 1024 + k) * INDIM + 2048 + j];
        }
        __syncthreads();
    }
    const bf16_t* raw = (const bf16_t*)(ws_fresh(p.ws) + OFF_RAW);
    bf16_t* xa = (bf16_t*)(ws_fresh(p.ws) + OFF_XB);
    float* rstd = (float*)(ws_fresh(p.ws) + OFF_RSTD);
    const float* gain = MODE == 1 ? p.n_mix_post + layer * 1024 : p.n_ffn_post + layer * 1024;
    f32x4 gn[4];
    if (MODE != 0) {
#pragma unroll
        for (int hh = 0; hh < 2; ++hh) { gn[2 * hh] = *(const f32x4*)(gain + hh * 512 + lane * 8); gn[2 * hh + 1] = *(const f32x4*)(gain + hh * 512 + lane * 8 + 4); }
    }
    constexpr int NR = 2;
    const int gw = bid * 8 + wid, nw = gridDim.x * 8;
    for (int rb = gw * NR; rb < TT; rb += nw * NR) {
        f32x4 x[NR][4];
        u32x4 rw[NR][2];
#pragma unroll
        for (int q = 0; q < NR; ++q) {
            const int r = rb + q;
            if (MODE == 0) {
                const float* res = r < TP ? p.xp + (size_t)r * 1024 : p.xs + (size_t)(r - TP) * 1024;
#pragma unroll
                for (int hh = 0; hh < 2; ++hh) { x[q][2 * hh] = *(const f32x4*)(res + hh * 512 + lane * 8); x[q][2 * hh + 1] = *(const f32x4*)(res + hh * 512 + lane * 8 + 4); }
            } else {
#pragma unroll
                for (int hh = 0; hh < 2; ++hh) {
                    const u32x4 v = *(const u32x4*)(xa + (size_t)r * 1024 + hh * 512 + lane * 8);
                    const float inv = 1.f / rstd[r];
                    x[q][2 * hh] = (f32x4){__uint_as_float(v.x << 16), __uint_as_float(v.x & 0xffff0000u), __uint_as_float(v.y << 16), __uint_as_float(v.y & 0xffff0000u)} * inv;
                    x[q][2 * hh + 1] = (f32x4){__uint_as_float(v.z << 16), __uint_as_float(v.z & 0xffff0000u), __uint_as_float(v.w << 16), __uint_as_float(v.w & 0xffff0000u)} * inv;
                    rw[q][hh] = __builtin_nontemporal_load((const u32x4*)(raw + (size_t)r * 1024 + hh * 512 + lane * 8));
                }
            }
        }
#pragma unroll
        for (int q = 0; q < NR; ++q) {
            const int r = rb + q;
            if (MODE != 0) {
                f32x4 f[4];
                if (rb >= TP) {
                    const float* ra = (const float*)(ws_fresh(p.ws) + OFF_PZ) + (size_t)(r - TP) * 1024 + lane * 8;
#pragma unroll
                    for (int i = 0; i < 4; ++i) f[i] = (f32x4){0.f, 0.f, 0.f, 0.f};
                    constexpr int NKC = MODE == 1 ? 4 : 11;
#pragma unroll 4
                    for (int kc = 0; kc < NKC; ++kc) {
                        const float* rk = ra + (size_t)kc * 262144;
                        const f32x4 t0 = *(const f32x4*)rk, t1 = *(const f32x4*)(rk + 4), t2 = *(const f32x4*)(rk + 512), t3 = *(const f32x4*)(rk + 516);
                        f[0] += t0; f[1] += t1; f[2] += t2; f[3] += t3;
                    }
                } else {
#pragma unroll
                    for (int hh = 0; hh < 2; ++hh) {
                        const u32x4 v = rw[q][hh];
                        f[2 * hh] = (f32x4){__uint_as_float(v.x << 16), __uint_as_float(v.x & 0xffff0000u), __uint_as_float(v.y << 16), __uint_as_float(v.y & 0xffff0000u)};
                        f[2 * hh + 1] = (f32x4){__uint_as_float(v.z << 16), __uint_as_float(v.z & 0xffff0000u), __uint_as_float(v.w << 16), __uint_as_float(v.w & 0xffff0000u)};
                    }
                }
                float ss = 0.f;
#pragma unroll
                for (int i = 0; i < 4; ++i) ss += f[i][0] * f[i][0] + f[i][1] * f[i][1] + f[i][2] * f[i][2] + f[i][3] * f[i][3];
                ss = wave_sum(ss);
                const float rs = rsqrtf(ss * (1.f / 1024.f) + 1e-6f);
#pragma unroll
                for (int i = 0; i < 4; ++i) x[q][i] += f[i] * rs * gn[i];
            }
            if (MODE == 3) {
                float* yo = p.out + O_Y + (size_t)r * 1024;
#pragma unroll
                for (int hh = 0; hh < 2; ++hh) { __builtin_nontemporal_store(x[q][2 * hh], (f32x4*)(yo + hh * 512 + lane * 8)); __builtin_nontemporal_store(x[q][2 * hh + 1], (f32x4*)(yo + hh * 512 + lane * 8 + 4)); }
            } else {
                float ss = 0.f;
#pragma unroll
                for (int i = 0; i < 4; ++i) ss += x[q][i][0] * x[q][i][0] + x[q][i][1] * x[q][i][1] + x[q][i][2] * x[q][i][2] + x[q][i][3] * x[q][i][3];
                ss = wave_sum(ss);
                const float rs = rsqrtf(ss * (1.f / 1024.f) + 1e-6f);
                if (lane == 0) rstd[r] = rs;
#pragma unroll
                for (int hh = 0; hh < 2; ++hh) {
                    const f32x4 n0 = x[q][2 * hh] * rs, n1 = x[q][2 * hh + 1] * rs;
                    u32x4 w; w.x = pk_bf16(n0[0], n0[1]); w.y = pk_bf16(n0[2], n0[3]); w.z = pk_bf16(n1[0], n1[1]); w.w = pk_bf16(n1[2], n1[3]);
                    *(u32x4*)(xa + (size_t)r * 1024 + hh * 512 + lane * 8) = w;
                }
                if (MODE == 0 || MODE == 2) {
                    float d[8];
#pragma unroll
                    for (int j = 0; j < 8; ++j) {
                        float a = 0.f;
#pragma unroll
                        for (int i = 0; i < 4; ++i) { const f32x4 w = *(const f32x4*)(wl + j * 1024 + (i >> 1) * 512 + lane * 8 + (i & 1) * 4); a += x[q][i][0] * w[0] + x[q][i][1] * w[1] + x[q][i][2] * w[2] + x[q][i][3] * w[3]; }
                        d[j] = wave_sum(a) * rs;
                    }
                    if (lane < 4) {
                        const float braw = lane == 0 ? d[0] : lane == 1 ? d[1] : lane == 2 ? d[2] : d[3];
                        const float araw = lane == 0 ? d[4] : lane == 1 ? d[5] : lane == 2 ? d[6] : d[7];
                        const float beta = 1.f / (1.f + __expf(-braw));
                        const float xv = araw + p.dt_bias[lnext * 4 + lane];
                        const float sp = xv > 20.f ? xv : log1pf(__expf(xv));
                        const float g = -__expf(p.a_log[lnext * 4 + lane]) * sp;
                        ((float*)(ws_fresh(p.ws) + OFF_BETA))[r * 4 + lane] = beta;
                        ((float*)(ws_fresh(p.ws) + OFF_GLOG))[r * 4 + lane] = g;
                    }
                }
            }
        }
    }
}

constexpr int KNS = 136;
constexpr int TBS = 72;
constexpr int C_QN = 0;
constexpr int C_KN = C_QN + 17408;
constexpr int C_VBT = C_KN + 17408;
constexpr int C_KBT = C_VBT + 18432;
constexpr int C_SM = C_KBT + 18432;
constexpr int C_AM = C_SM + 2048;
constexpr int C_TF = C_AM + 16384;
constexpr int C_TB = C_TF + 16384;
constexpr int C_QKL = C_TB + 9216;
constexpr int C_WL = C_QKL + 9216;
static_assert(C_WL + 17408 <= LDS_BYTES - 16, "lds");
#define LBAR() do { asm volatile("s_waitcnt lgkmcnt(0)" ::: "memory"); __builtin_amdgcn_s_barrier(); asm volatile("" ::: "memory"); } while (0)
DI f32x4 bflo4(const u32x4& v) { return (f32x4){__uint_as_float(v.x << 16), __uint_as_float(v.x & 0xffff0000u), __uint_as_float(v.y << 16), __uint_as_float(v.y & 0xffff0000u)}; }
DI f32x4 bfhi4(const u32x4& v) { return (f32x4){__uint_as_float(v.z << 16), __uint_as_float(v.z & 0xffff0000u), __uint_as_float(v.w << 16), __uint_as_float(v.w & 0xffff0000u)}; }
DI float row16_sum(float v) {
    v += __builtin_bit_cast(float, __builtin_amdgcn_update_dpp(0, __builtin_bit_cast(int, v), 0xB1, 0xf, 0xf, true));
    v += __builtin_bit_cast(float, __builtin_amdgcn_update_dpp(0, __builtin_bit_cast(int, v), 0x4E, 0xf, 0xf, true));
    v += __builtin_bit_cast(float, __builtin_amdgcn_update_dpp(0, __builtin_bit_cast(int, v), 0x141, 0xf, 0xf, true));
    v += __builtin_bit_cast(float, __builtin_amdgcn_update_dpp(0, __builtin_bit_cast(int, v), 0x140, 0xf, 0xf, true));
    return v;
}
DI float silu_fast(float x) { return x * __builtin_amdgcn_rcpf(1.f + __expf(-x)); }

DI void write_frags_rowmajor(const bf16_t* X, int ldx, int KS, int nfr, const float* rowscale, __amdgpu_buffer_rsrc_t rs, unsigned dofs, int t0, int nthr) {
    for (int it = t0; it < nfr * 64; it += nthr) {
        const int f = it >> 6, l = it & 63, mt = f / KS, ks = f % KS, m = mt * 16 + (l & 15), g = l >> 4;
        const bf16_t* rp = X + m * ldx + ks * 32 + 4 * g;
        const u32x2 lo = *(const u32x2*)rp, hi = *(const u32x2*)(rp + 16);
        u32x4 o;
        if (rowscale) {
            const float s = rowscale[m];
            o.x = pk_bf16(__uint_as_float(lo.x << 16) * s, __uint_as_float(lo.x & 0xffff0000u) * s);
            o.y = pk_bf16(__uint_as_float(lo.y << 16) * s, __uint_as_float(lo.y & 0xffff0000u) * s);
            o.z = pk_bf16(__uint_as_float(hi.x << 16) * s, __uint_as_float(hi.x & 0xffff0000u) * s);
            o.w = pk_bf16(__uint_as_float(hi.y << 16) * s, __uint_as_float(hi.y & 0xffff0000u) * s);
        } else { o.x = lo.x; o.y = lo.y; o.z = hi.x; o.w = hi.y; }
        __builtin_amdgcn_raw_buffer_store_b128(o, rs, dofs + (unsigned)it * 16u, 0, 16);
    }
}

DI void phase_chunk(const Params& p, int layer, unsigned char* smem, int first_block, int nblk) {
    const int tid = tid_fresh(), wid = tid >> 6, lane = tid & 63, bid = bid_fresh();
    bf16_t* QN = (bf16_t*)(smem + C_QN);
    bf16_t* KN = (bf16_t*)(smem + C_KN);
    bf16_t* VBT = (bf16_t*)(smem + C_VBT);
    bf16_t* KBT = (bf16_t*)(smem + C_KBT);
    bf16_t* QKL = (bf16_t*)(smem + C_QKL);
    bf16_t* TB = (bf16_t*)(smem + C_TB);
    float* SM = (float*)(smem + C_SM);
    float *GC = SM, *BETA = SM + 64, *EG = SM + 128, *EGL = SM + 192, *QS = SM + 256, *KS_ = SM + 320, *BE = SM + 384;
    float* AM = (float*)(smem + C_AM);
    float* TF = (float*)(smem + C_TF);
    bf16_t* WL = (bf16_t*)(smem + C_WL);
    const bf16_t* pqkv = (const bf16_t*)(ws_fresh(p.ws) + OFF_PQKV);
    const bf16_t* psc = (const bf16_t*)(ws_fresh(p.ws) + OFF_PSC);
    bf16_t* mixin = (bf16_t*)(p.out + O_Y);
    const float* betaA = (const float*)(ws_fresh(p.ws) + OFF_BETA);
    const float* glogA = (const float*)(ws_fresh(p.ws) + OFF_GLOG);

    unsigned* readyc = (unsigned*)(ws_fresh(p.ws) + OFF_FLAG) + layer * 528;
    int pending_c = -1;
    u32x4 raw[11];
    float gvp = 0.f, bvp = 0.f;
    auto issue_loads = [&](const int o2) __attribute__((always_inline)) {
        const int u2 = o2 < 2048 ? ((((o2 >> 2) & 1) * 256 + (o2 >> 3)) * 4 + (o2 & 3)) : o2;
        const int c2 = u2 >> 2, h2 = u2 & 3;
        int row02, nvalid2; bool first2;
        if (c2 < 512) { const int b2 = c2 >> 8, n2 = c2 & 255; row02 = b2 * 16384 + n2 * 64; nvalid2 = 64; first2 = n2 == 0; }
        else { row02 = TP + (c2 - 512) * 16; nvalid2 = 16; first2 = true; }
        const int tid2 = tid_fresh();
        if (tid2 < 384) {
            const int rg2 = tid2 / 48, cg2 = tid2 % 48, col02 = (cg2 >> 4) * 512 + h2 * 128 + (cg2 & 15) * 8;
#pragma unroll
            for (int i = 0; i < 11; ++i) {
                int rr = rg2 * 8 - 3 + i;
                if (rr >= nvalid2) rr = 0;
                if (rr < 0 && first2) rr = 0;
                raw[i] = *(const u32x4*)(pqkv + (size_t)(row02 + rr) * 1536 + col02);
            }
        }
        if ((tid2 >> 6) == 7) {
            const int l2 = tid2 & 63, rl = l2 < nvalid2 ? l2 : 0;
            gvp = glogA[(size_t)(row02 + rl) * 4 + h2]; bvp = betaA[(size_t)(row02 + rl) * 4 + h2];
        }
    };
    if (bid - first_block < NCHH) issue_loads(bid - first_block);
    for (int o = bid - first_block; o < NCHH; o += nblk) {
        const int u = o < 2048 ? ((((o >> 2) & 1) * 256 + (o >> 3)) * 4 + (o & 3)) : o;
        const int c = u >> 2, h = u & 3;
        int row0, nvalid, sb = 0; bool first, lastc, prompt = c < 512;
        if (prompt) { const int b = c >> 8, n = c & 255; row0 = b * 16384 + n * 64; nvalid = 64; first = n == 0; lastc = n == 255; sb = b; }
        else { sb = c - 512; row0 = TP + sb * 16; nvalid = 16; first = true; lastc = true; }
        unsigned char* frb = ws_fresh(p.ws) + OFF_FR + (size_t)u * FR_STRIDE;
        const __amdgpu_buffer_rsrc_t frr = __builtin_amdgcn_make_buffer_rsrc(frb, 0, (int)FR_STRIDE, 0x00020000);

        const int rg = tid / 48, cg = tid % 48, which = cg >> 4, c0 = (cg & 15) * 8, col0 = which * 512 + h * 128 + c0, r0 = rg * 8;
        const bool use_cache = (tid < 384) && rg == 0 && first && !prompt;
        if (wid == 7) {
            const int r = lane;
            const float gv = r < nvalid ? gvp : 0.f, bv = r < nvalid ? bvp : 0.f;
            float cs = gv;
#pragma unroll
            for (int o = 1; o < 64; o <<= 1) { const float t = __shfl_up(cs, o); if (lane >= o) cs += t; }
            const float gl = __shfl(cs, 63);
            const float egv = __expf(cs); GC[r] = cs; BETA[r] = bv; EG[r] = egv; BE[r] = bv * egv; EGL[r] = __expf(gl - cs);
            const float alx = __expf(gl);
            if (r == 0) __hip_atomic_store((float*)(ws_fresh(p.ws) + OFF_AL) + u, alx, __ATOMIC_RELAXED, __HIP_MEMORY_SCOPE_AGENT);
            { const unsigned ab = __float_as_uint(alx); __builtin_amdgcn_raw_buffer_store_b128((u32x4){ab, ab, ab, ab}, frr, (unsigned)(FR_META + lane * 16), 0, 16); }
        }
        asm volatile("s_waitcnt vmcnt(0)" ::: "memory");
        __syncthreads();
        if (pending_c >= 0 && tid == 0) __hip_atomic_fetch_add(readyc + pending_c, 1u, __ATOMIC_RELAXED, __HIP_MEMORY_SCOPE_AGENT);
        if (tid < 384) {
            const float* cw = p.conv_w + layer * 4 * 1536 + col0;
            f32x4 wv[4][2];
#pragma unroll
            for (int i = 0; i < 4; ++i) { wv[i][0] = *(const f32x4*)(cw + i * 1536); wv[i][1] = *(const f32x4*)(cw + i * 1536 + 4); }
            f32x4 xin[11][2];
#pragma unroll
            for (int i = 0; i < 11; ++i) {
                xin[i][0] = bflo4(raw[i]); xin[i][1] = bfhi4(raw[i]);
                if (i < 3 && rg == 0 && first) {
                    if (use_cache) {
                        const float* cp = p.cache_conv + ((size_t)(layer * 16 + sb) * 3 + i) * 1536 + col0;
                        xin[i][0] = *(const f32x4*)cp; xin[i][1] = *(const f32x4*)(cp + 4);
                    } else { xin[i][0] = (f32x4){0.f, 0.f, 0.f, 0.f}; xin[i][1] = xin[i][0]; }
                }
            }
            if (lastc && r0 + 8 == ((nvalid + 7) & ~7) ) {
                float* co = prompt ? p.out + O_CONVP + ((size_t)(layer * 2 + sb) * 3) * 1536 + col0 : p.out + O_CONVS + ((size_t)(layer * 16 + sb) * 3) * 1536 + col0;
                const int jl = nvalid - 1 - r0;
#pragma unroll
                for (int i = 0; i < 3; ++i) { *(f32x4*)(co + i * 1536) = xin[jl + 1 + i][0]; *(f32x4*)(co + i * 1536 + 4) = xin[jl + 1 + i][1]; }
            }
#pragma unroll
            for (int hf = 0; hf < 2; ++hf) {
                float yv[4][8];
#pragma unroll
                for (int jj = 0; jj < 4; ++jj) {
                    const int j = hf * 4 + jj;
                    const bool valid = r0 + j < nvalid;
                    const f32x4 a0 = wv[0][0] * xin[j][0] + wv[1][0] * xin[j + 1][0] + wv[2][0] * xin[j + 2][0] + wv[3][0] * xin[j + 3][0];
                    const f32x4 a1 = wv[0][1] * xin[j][1] + wv[1][1] * xin[j + 1][1] + wv[2][1] * xin[j + 2][1] + wv[3][1] * xin[j + 3][1];
#pragma unroll
                    for (int e = 0; e < 4; ++e) { yv[jj][e] = valid ? silu_fast(a0[e]) : 0.f; yv[jj][4 + e] = valid ? silu_fast(a1[e]) : 0.f; }
                }
                if (which < 2) {
                    bf16_t* dstn = (which ? KN : QN);
#pragma unroll
                    for (int jj = 0; jj < 4; ++jj) {
                        float ss = 0.f;
#pragma unroll
                        for (int e = 0; e < 8; ++e) ss += yv[jj][e] * yv[jj][e];
                        ss = row16_sum(ss);
                        const float sc = rsqrtf(ss + 1e-6f) * (which ? 1.f : 0.08838834764831845f);
#pragma unroll
                        for (int e = 0; e < 8; ++e) yv[jj][e] *= sc;
                        u32x4 w; w.x = pk_bf16(yv[jj][0], yv[jj][1]); w.y = pk_bf16(yv[jj][2], yv[jj][3]); w.z = pk_bf16(yv[jj][4], yv[jj][5]); w.w = pk_bf16(yv[jj][6], yv[jj][7]);
                        *(u32x4*)(dstn + (r0 + hf * 4 + jj) * KNS + c0) = w;
                    }
                }
                if (which >= 1) {
                    bf16_t* dstt = (which == 1 ? KBT : VBT);
                    const float* scl = (which == 1 ? BE : BETA);
                    float sc4[4];
#pragma unroll
                    for (int jj = 0; jj < 4; ++jj) sc4[jj] = scl[r0 + hf * 4 + jj];
#pragma unroll
                    for (int e = 0; e < 8; ++e) {
                        u32x2 w; w.x = pk_bf16(yv[0][e] * sc4[0], yv[1][e] * sc4[1]); w.y = pk_bf16(yv[2][e] * sc4[2], yv[3][e] * sc4[3]);
                        *(u32x2*)(dstt + (c0 + e) * TBS + r0 + hf * 4) = w;
                    }
                }
            }
        } else {
#pragma unroll 1
            for (int kb = 0; kb < 2; ++kb) {
                u32x4 scv[2][4], shv[2][4], sbv[2][2];
#pragma unroll
                for (int k2 = 0; k2 < 2; ++k2) {
                    const int it = (tid - 384) + 128 * (kb * 2 + k2), sr0 = (it >> 4) * 2, ch0 = h * 128 + (it & 15) * 8;
#pragma unroll
                    for (int i = 0; i < 4; ++i) {
                        int rr = sr0 - 2 + i;
                        if (rr >= nvalid) rr = 0;
                        if (rr < 0 && first) rr = 0;
                        const bf16_t* rp = psc + (size_t)(row0 + rr) * 1536 + ch0;
                        scv[k2][i] = *(const u32x4*)(rp + 512); shv[k2][i] = *(const u32x4*)(rp + 1024);
                        if (i >= 2) sbv[k2][i - 2] = *(const u32x4*)rp;
                    }
                }
#pragma unroll
                for (int k2 = 0; k2 < 2; ++k2) {
                    const int it = (tid - 384) + 128 * (kb * 2 + k2), sr0 = (it >> 4) * 2, ch0 = h * 128 + (it & 15) * 8;
                    if (sr0 < nvalid) {
                        const float* cw = p.conv_sc_w + layer * 3 * 512 + ch0;
                        f32x4 wv[3][2];
#pragma unroll
                        for (int i = 0; i < 3; ++i) { wv[i][0] = *(const f32x4*)(cw + i * 512); wv[i][1] = *(const f32x4*)(cw + i * 512 + 4); }
                        f32x4 pr[4][2];
#pragma unroll
                        for (int i = 0; i < 4; ++i) {
                            const int rr = sr0 - 2 + i;
                            if (rr < 0 && first) {
                                if (prompt) { pr[i][0] = (f32x4){0.f, 0.f, 0.f, 0.f}; pr[i][1] = pr[i][0]; }
                                else { const float* cp = p.cache_sc + ((size_t)(layer * 16 + sb) * 2 + (rr + 2)) * 512 + ch0; pr[i][0] = *(const f32x4*)cp; pr[i][1] = *(const f32x4*)(cp + 4); }
                            } else { pr[i][0] = bflo4(scv[k2][i]) * bflo4(shv[k2][i]); pr[i][1] = bfhi4(scv[k2][i]) * bfhi4(shv[k2][i]); }
                        }
#pragma unroll
                        for (int j = 0; j < 2; ++j) {
                            const u32x4 bvv = sbv[k2][j];
                            const f32x4 y0 = bflo4(bvv) * (wv[0][0] * pr[j][0] + wv[1][0] * pr[j + 1][0] + wv[2][0] * pr[j + 2][0]);
                            const f32x4 y1 = bfhi4(bvv) * (wv[0][1] * pr[j][1] + wv[1][1] * pr[j + 1][1] + wv[2][1] * pr[j + 2][1]);
                            u32x4 w; w.x = pk_bf16(y0[0], y0[1]); w.y = pk_bf16(y0[2], y0[3]); w.z = pk_bf16(y1[0], y1[1]); w.w = pk_bf16(y1[2], y1[3]);
                            *(u32x4*)(mixin + (size_t)(row0 + sr0 + j) * 1024 + 512 + ch0) = w;
                        }
                        if (lastc && sr0 == nvalid - 2) {
                            float* co = prompt ? p.out + O_SCP + ((size_t)(layer * 2 + sb) * 2) * 512 + ch0 : p.out + O_SCS + ((size_t)(layer * 16 + sb) * 2) * 512 + ch0;
                            *(f32x4*)co = pr[2][0]; *(f32x4*)(co + 4) = pr[2][1]; *(f32x4*)(co + 512) = pr[3][0]; *(f32x4*)(co + 516) = pr[3][1];
                        }
                    }
                }
            }
        }
        __syncthreads();
        const int tidb = tid_fresh(), widb = tidb >> 6, laneb = tidb & 63;
        for (int job = widb; job < 32; job += 8) {
            const int isqk = job >> 4, mi = (job >> 2) & 3, nj = job & 3;
            const int g = laneb >> 4, n = laneb & 15;
            if (mi < nj) {
#pragma unroll
                for (int e = 0; e < 4; ++e) { bf16_t* dst = (isqk ? QKL : TB) + (mi * 16 + 4 * g + e) * TBS + nj * 16 + n; *dst = 0; }
                continue;
            }
            const bf16_t* Arow = (isqk ? QN : KN) + (mi * 16 + n) * KNS + g * 8;
            const bf16_t* Brow = KN + (nj * 16 + n) * KNS + g * 8;
            f32x4 acc = {0.f, 0.f, 0.f, 0.f};
#pragma unroll
            for (int ks = 0; ks < 4; ++ks) {
                const bf16x8 a = *(const bf16x8*)(Arow + ks * 32), b = *(const bf16x8*)(Brow + ks * 32);
                acc = MFMA16(a, b, acc);
            }
            const int j = nj * 16 + n; const float gj = GC[j];
            if (isqk) {
#pragma unroll
                for (int e = 0; e < 4; ++e) {
                    const int i = mi * 16 + 4 * g + e;
                    const float v = (i >= j) ? acc[e] * __expf(GC[i] - gj) : 0.f; QKL[i * TBS + j] = f2bf(v);
                }
            } else {
                f32x4 v;
#pragma unroll
                for (int e = 0; e < 4; ++e) { const int i = mi * 16 + 4 * g + e; v[e] = (i > j) ? acc[e] * BETA[i] * __expf(GC[i] - gj) : 0.f; }
                *(f32x4*)(AM + j * 64 + mi * 16 + 4 * g) = v;
            }
        }
        __syncthreads();
        if (widb == 0) {
            const int b = laneb >> 4, cx = laneb & 15;
            const float* Ab = AM + (16 * b) * 64 + 16 * b;
            float x[16];
#pragma unroll
            for (int i = 0; i < 16; ++i) {
                float a = (i == cx) ? 1.f : 0.f;
#pragma unroll
                for (int j = 0; j < i; ++j) a -= Ab[j * 64 + i] * x[j];
                x[i] = a;
            }
#pragma unroll
            for (int i = 0; i < 16; ++i) { TF[(16 * b + i) * 64 + 16 * b + cx] = x[i]; TB[(16 * b + i) * TBS + 16 * b + cx] = f2bf(x[i]); }
        } else if (widb >= 4) {
            const int t0 = tidb - 256;
            write_frags_rowmajor(QN, KNS, 4, 16, EG, frr, (unsigned)FR_QG, t0, 256);
            write_frags_rowmajor(QKL, TBS, 2, 8, nullptr, frr, (unsigned)FR_QK, t0, 256);
            for (int it = t0; it < 16 * 64; it += 256) {
                const int f = it >> 6, l = it & 63, mt = f >> 1, ks = f & 1, m = mt * 16 + (l & 15), g = l >> 4;
                float v[8];
#pragma unroll
                for (int e = 0; e < 8; ++e) { const int j = ks * 32 + 16 * (e >> 2) + 4 * g + (e & 3); v[e] = bf2f(KN[j * KNS + m]) * EGL[j]; }
                u32x4 o; o.x = pk_bf16(v[0], v[1]); o.y = pk_bf16(v[2], v[3]); o.z = pk_bf16(v[4], v[5]); o.w = pk_bf16(v[6], v[7]);
                __builtin_amdgcn_raw_buffer_store_b128(o, frr, (unsigned)(FR_KT + it * 16), 0, 16);
            }
        }
        __syncthreads();
        if (o + nblk < NCHH) issue_loads(o + nblk);
#pragma unroll
        for (int d = 1; d < 4; ++d) {
            if (widb < 4 - d) {
                const int b = widb, bi = b + d, g = laneb >> 4, n = laneb & 15;
                f32x4 acc = {0.f, 0.f, 0.f, 0.f};
                for (int k = b; k < bi; ++k) {
#pragma unroll
                    for (int ks = 0; ks < 4; ++ks) {
                        const float av = AM[(16 * k + 4 * ks + g) * 64 + 16 * bi + n];
                        const float bv = TF[(16 * k + 4 * ks + g) * 64 + 16 * b + n];
                        acc = __builtin_amdgcn_mfma_f32_16x16x4f32(av, bv, acc, 0, 0, 0);
                    }
                }
                f32x4 res = {0.f, 0.f, 0.f, 0.f};
#pragma unroll
                for (int e = 0; e < 4; ++e) {
                    const float dv = TF[(16 * bi + n) * 64 + 16 * bi + 4 * g + e];
                    res = __builtin_amdgcn_mfma_f32_16x16x4f32(dv, acc[e], res, 0, 0, 0);
                }
#pragma unroll
                for (int e = 0; e < 4; ++e) { const int i = 16 * bi + 4 * g + e; TF[i * 64 + 16 * b + n] = -res[e]; TB[i * TBS + 16 * b + n] = f2bf(-res[e]); }
            }
            LBAR();
        }
        {
            const int g = laneb >> 4, n = laneb & 15;
            bf16x8 ta[4][2];
#pragma unroll
            for (int mt = 0; mt < 4; ++mt)
#pragma unroll
                for (int ks = 0; ks < 2; ++ks) ta[mt][ks] = *(const bf16x8*)(TB + (mt * 16 + n) * TBS + ks * 32 + g * 8);
            f32x4 uo[4], wo[4];
#pragma unroll
            for (int mt = 0; mt < 4; ++mt) { uo[mt] = (f32x4){0.f, 0.f, 0.f, 0.f}; wo[mt] = (f32x4){0.f, 0.f, 0.f, 0.f}; }
#pragma unroll
            for (int ks = 0; ks < 2; ++ks) {
                const bf16x8 bu = *(const bf16x8*)(VBT + (widb * 16 + n) * TBS + ks * 32 + g * 8);
                const bf16x8 bw = *(const bf16x8*)(KBT + (widb * 16 + n) * TBS + ks * 32 + g * 8);
#pragma unroll
                for (int mt = 0; mt < 4; ++mt) { uo[mt] = MFMA16(ta[mt][ks], bu, uo[mt]); wo[mt] = MFMA16(ta[mt][ks], bw, wo[mt]); }
            }
            u32x4 a, b2;
            a.x = pk_bf16(uo[0][0], uo[0][1]); a.y = pk_bf16(uo[0][2], uo[0][3]); a.z = pk_bf16(uo[1][0], uo[1][1]); a.w = pk_bf16(uo[1][2], uo[1][3]);
            b2.x = pk_bf16(uo[2][0], uo[2][1]); b2.y = pk_bf16(uo[2][2], uo[2][3]); b2.z = pk_bf16(uo[3][0], uo[3][1]); b2.w = pk_bf16(uo[3][2], uo[3][3]);
            const unsigned uofs = (unsigned)(FR_U + (widb * 64 + laneb) * 32);
            __builtin_amdgcn_raw_buffer_store_b128(a, frr, uofs, 0, 16); __builtin_amdgcn_raw_buffer_store_b128(b2, frr, uofs + 16u, 0, 16);
#pragma unroll
            for (int mt = 0; mt < 4; ++mt)
#pragma unroll
                for (int e = 0; e < 4; ++e) WL[(mt * 16 + 4 * g + e) * KNS + widb * 16 + n] = f2bf(wo[mt][e]);
        }
        LBAR();
        write_frags_rowmajor(WL, KNS, 4, 16, nullptr, frr, (unsigned)FR_W, tidb, 512);
        pending_c = c;
    }
    asm volatile("s_waitcnt vmcnt(0)" ::: "memory");
    __syncthreads();
    if (pending_c >= 0 && tid == 0) __hip_atomic_fetch_add(readyc + pending_c, 1u, __ATOMIC_RELAXED, __HIP_MEMORY_SCOPE_AGENT);
}

DI void scan_task(const Params& p, int layer, int u0, int nsteps, const float* s0, float* sout, int s, int lane) {
    const int g = lane >> 4, n = lane & 15;
    f32x4 S[8];
#pragma unroll
    for (int mt = 0; mt < 8; ++mt)
#pragma unroll
        for (int e = 0; e < 4; ++e) S[mt][e] = s0 ? s0[(size_t)(mt * 16 + 4 * g + e) * 128 + s * 16 + n] : 0.f;
    const float* alA = (const float*)(ws_fresh(p.ws) + OFF_AL);
    for (int st = 0; st < nsteps; ++st) {
        const int u = u0 + st * 4;
        const unsigned char* frb = ws_fresh(p.ws) + OFF_FR + (size_t)u * FR_STRIDE;
        const u32x4* wf = (const u32x4*)(frb + FR_W) + lane;
        const u32x4* kf = (const u32x4*)(frb + FR_KT) + lane;
        const u32x4* uf = (const u32x4*)(frb + FR_U + (size_t)(s * 64 + lane) * 32);
        bf16x8 Sb[4];
#pragma unroll
        for (int ks = 0; ks < 4; ++ks) Sb[ks] = pack8(S[2 * ks], S[2 * ks + 1]);
        u32x4* sfr = (u32x4*)(sv_home(p, u) + (size_t)s * 4096) + lane;
#pragma unroll
        for (int ks = 0; ks < 4; ++ks) sfr[ks * 64] = __builtin_bit_cast(u32x4, Sb[ks]);
        const u32x4 u0v = uf[0], u1v = uf[1];
        f32x4 vn[4];
#pragma unroll
        for (int mt = 0; mt < 4; ++mt) {
            f32x4 acc = {0.f, 0.f, 0.f, 0.f};
#pragma unroll
            for (int ks = 0; ks < 4; ++ks) acc = MFMA16(__builtin_bit_cast(bf16x8, wf[(mt * 4 + ks) * 64]), Sb[ks], acc);
            const unsigned lo = mt == 0 ? u0v.x : mt == 1 ? u0v.z : mt == 2 ? u1v.x : u1v.z;
            const unsigned hi = mt == 0 ? u0v.y : mt == 1 ? u0v.w : mt == 2 ? u1v.y : u1v.w;
            vn[mt][0] = __uint_as_float(lo << 16) - acc[0]; vn[mt][1] = __uint_as_float(lo & 0xffff0000u) - acc[1];
            vn[mt][2] = __uint_as_float(hi << 16) - acc[2]; vn[mt][3] = __uint_as_float(hi & 0xffff0000u) - acc[3];
        }
        bf16x8 Vb[2];
        Vb[0] = pack8(vn[0], vn[1]); Vb[1] = pack8(vn[2], vn[3]);
        u32x4* vfr = (u32x4*)(sv_home(p, u) + 32768 + (size_t)s * 2048) + lane;
        vfr[0] = __builtin_bit_cast(u32x4, Vb[0]); vfr[64] = __builtin_bit_cast(u32x4, Vb[1]);
        const float al = alA[u];
#pragma unroll
        for (int mt = 0; mt < 8; ++mt) {
            S[mt] *= al;
#pragma unroll
            for (int ks = 0; ks < 2; ++ks) S[mt] = MFMA16(__builtin_bit_cast(bf16x8, kf[(mt * 2 + ks) * 64]), Vb[ks], S[mt]);
        }
    }
#pragma unroll
    for (int mt = 0; mt < 8; ++mt)
#pragma unroll
        for (int e = 0; e < 4; ++e) sout[(size_t)(mt * 16 + 4 * g + e) * 128 + s * 16 + n] = S[mt][e];
}
constexpr int SC_SLOT = 35840, SC_D = 3;
DI void scan_prompt(const Params& p, int layer, LAS unsigned char* lds, int tid, int b) {
    const int wid = __builtin_amdgcn_readfirstlane(tid >> 6), lane = tid & 63, g = lane >> 4, n = lane & 15;
    const int xcd = b & 7, s = b >> 3, bb = xcd >> 2, h = xcd & 3;
    const int u0 = (bb * 256) * 4 + h;
    const unsigned char* fr0 = ws_fresh(p.ws) + OFF_FR + (size_t)u0 * FR_STRIDE;
    const size_t stepB = 4 * FR_STRIDE;
    unsigned* readyc = (unsigned*)(ws_fresh(p.ws) + OFF_FLAG) + layer * 528 + bb * 256;
#define SC_ISSUE(st, slot) do { const unsigned char* _f = fr0 + (size_t)(st) * stepB; \
        _Pragma("unroll") for (int _i = 0; _i < 6; ++_i) { const int _q = (wid - 2) * 6 + _i; if (_q < 35) { \
            const unsigned char* _src = _q < 32 ? _f + _q * 1024 + lane * 16 : _q < 34 ? _f + FR_U + (size_t)(s * 64 + lane) * 32 + (_q - 32) * 16 : _f + FR_META + lane * 16; \
            __builtin_amdgcn_global_load_lds((const unsigned*)_src, (LAS unsigned*)(lds + (slot) * SC_SLOT + _q * 1024), 16, 0, 0); } } } while (0)
    f32x4 S[8];
#pragma unroll
    for (int mt = 0; mt < 8; ++mt) S[mt] = (f32x4){0.f, 0.f, 0.f, 0.f};
    if (wid == 1) { wait_counts8(readyc, 0, 255, lane, 4u); wait_counts8(readyc, 3, 255, lane, 4u); }
    asm volatile("" ::: "memory");
    __builtin_amdgcn_s_barrier();
    asm volatile("" ::: "memory");
    if (wid >= 2) {
#pragma unroll
        for (int st = 0; st < SC_D; ++st) SC_ISSUE(st, st);
    }
    if (wid == 7) asm volatile("s_waitcnt vmcnt(10)" ::: "memory");
    else if (wid >= 2) asm volatile("s_waitcnt vmcnt(12)" ::: "memory");
    asm volatile("" ::: "memory");
    __builtin_amdgcn_s_barrier();
    asm volatile("" ::: "memory");
    if (wid >= 2) SC_ISSUE(SC_D, SC_D & 3);
    bf16x8 wfr[16]; u32x4 u0v = {0u, 0u, 0u, 0u}, u1v = {0u, 0u, 0u, 0u}; float al = 0.f;
    if (wid == 0) {
        LAS const unsigned char* sb = lds + lane * 16;
        u0v = *(LAS const u32x4*)(sb + 32768); u1v = *(LAS const u32x4*)(sb + 33792); al = *(LAS const float*)(lds + 34816);
#pragma unroll
        for (int f = 0; f < 16; ++f) wfr[f] = *(LAS const bf16x8*)(sb + f * 1024);
    }
    for (int st = 0; st < 256; ++st) {
        const int k = st + 1;
        if (wid != 0) {
            if (wid == 1) { if ((k & 7) == 0 && k + SC_D < 256) wait_counts8(readyc, k + SC_D, 255, lane, 4u); }
            else if (wid == 7) asm volatile("s_waitcnt vmcnt(10)" ::: "memory");
            else asm volatile("s_waitcnt vmcnt(12)" ::: "memory");
            asm volatile("" ::: "memory");
            __builtin_amdgcn_s_barrier();
            asm volatile("" ::: "memory");
            if (wid >= 2) { const int nx = k + SC_D < 256 ? k + SC_D : 255; SC_ISSUE(nx, (k + SC_D) & 3); }
        } else {
            const int u = u0 + st * 4;
            LAS const unsigned char* sb = lds + (st & 3) * SC_SLOT + lane * 16;
            unsigned char* svh = sv_home(p, u);
            bf16x8 Sb[4];
#pragma unroll
            for (int ks = 0; ks < 4; ++ks) Sb[ks] = pack8(S[2 * ks], S[2 * ks + 1]);
            u32x4* sfr = (u32x4*)(svh + (size_t)s * 4096) + lane;
#pragma unroll
            for (int ks = 0; ks < 4; ++ks) sfr[ks * 64] = __builtin_bit_cast(u32x4, Sb[ks]);
            f32x4 vn[4];
#pragma unroll
            for (int mt = 0; mt < 4; ++mt) vn[mt] = (f32x4){0.f, 0.f, 0.f, 0.f};
#pragma unroll
            for (int ks = 0; ks < 4; ++ks)
#pragma unroll
                for (int mt = 0; mt < 4; ++mt) vn[mt] = MFMA16(wfr[mt * 4 + ks], Sb[ks], vn[mt]);
            __builtin_amdgcn_sched_barrier(0);
            bf16x8 kfr[16];
#pragma unroll
            for (int f = 0; f < 16; ++f) kfr[f] = *(LAS const bf16x8*)(sb + 16384 + f * 1024);
#pragma unroll
            for (int mt = 0; mt < 4; ++mt) {
                const unsigned lo = mt == 0 ? u0v.x : mt == 1 ? u0v.z : mt == 2 ? u1v.x : u1v.z;
                const unsigned hi = mt == 0 ? u0v.y : mt == 1 ? u0v.w : mt == 2 ? u1v.y : u1v.w;
                vn[mt][0] = __uint_as_float(lo << 16) - vn[mt][0]; vn[mt][1] = __uint_as_float(lo & 0xffff0000u) - vn[mt][1];
                vn[mt][2] = __uint_as_float(hi << 16) - vn[mt][2]; vn[mt][3] = __uint_as_float(hi & 0xffff0000u) - vn[mt][3];
            }
            bf16x8 Vb[2];
            Vb[0] = pack8(vn[0], vn[1]); Vb[1] = pack8(vn[2], vn[3]);
            u32x4* vfr = (u32x4*)(svh + 32768 + (size_t)s * 2048) + lane;
            vfr[0] = __builtin_bit_cast(u32x4, Vb[0]); vfr[64] = __builtin_bit_cast(u32x4, Vb[1]);
            const float alc = al;
            asm volatile("s_waitcnt lgkmcnt(0)" ::: "memory");
            __builtin_amdgcn_sched_barrier(0);
            __builtin_amdgcn_s_barrier();
            asm volatile("" ::: "memory");
            __builtin_amdgcn_sched_barrier(0);
            if (k < 256) {
                LAS const unsigned char* sn = lds + (k & 3) * SC_SLOT + lane * 16;
                u0v = *(LAS const u32x4*)(sn + 32768); u1v = *(LAS const u32x4*)(sn + 33792); al = *(LAS const float*)(lds + (k & 3) * SC_SLOT + 34816);
#pragma unroll
                for (int f = 0; f < 16; ++f) wfr[f] = *(LAS const bf16x8*)(sn + f * 1024);
            }
            __builtin_amdgcn_sched_barrier(0);
#pragma unroll
            for (int mt = 0; mt < 8; ++mt) S[mt] *= alc;
#pragma unroll
            for (int ks = 0; ks < 2; ++ks)
#pragma unroll
                for (int mt = 0; mt < 8; ++mt) S[mt] = MFMA16(kfr[mt * 2 + ks], Vb[ks], S[mt]);
        }
    }
    if (wid >= 2) asm volatile("s_waitcnt vmcnt(0)" ::: "memory");
    else if (wid == 0) {
        float* sout = p.out + O_STP + ((size_t)(layer * 2 + bb) * 4 + h) * 16384;
#pragma unroll
        for (int mt = 0; mt < 8; ++mt)
#pragma unroll
            for (int e = 0; e < 4; ++e) sout[(size_t)(mt * 16 + 4 * g + e) * 128 + s * 16 + n] = S[mt][e];
    }
#undef SC_ISSUE
}
DI void phase_chunk_scan(const Params& p, int layer, unsigned char* smem, LAS unsigned char* lds) {
    const int b = bid_fresh();
    if (b < 64) {
        scan_prompt(p, layer, lds, tid_fresh(), b);
    } else {
        phase_chunk(p, layer, smem, 64, (int)gridDim.x - 64);
        const int tid = tid_fresh(), wid = tid >> 6, lane = tid & 63;
        unsigned* readyc = (unsigned*)(ws_fresh(p.ws) + OFF_FLAG) + layer * 528;
        for (int t = (b - 64) * 8 + wid; t < 512; t += (gridDim.x - 64) * 8) {
            const int sb = t >> 5, h = (t >> 3) & 3, s = t & 7;
            wait_count(readyc + 512 + sb, 4u);
            scan_task(p, layer, (512 + sb) * 4 + h, 1, p.state0 + ((size_t)(layer * 16 + sb) * 4 + h) * 16384,
                      p.out + O_STS + ((size_t)(layer * 16 + sb) * 4 + h) * 16384, s, lane);
        }
    }
}

DI void phase_out(const Params& p, int layer) {
    const int tid = tid_fresh(), wid = tid >> 6, lane = tid & 63, g = lane >> 4, n = lane & 15, bid = bid_fresh();
    const bf16_t* pz = (const bf16_t*)(ws_fresh(p.ws) + OFF_PZ);
    bf16_t* mixin = (bf16_t*)(p.out + O_Y);
    f32x4 gwv[8];
#pragma unroll
    for (int s = 0; s < 8; ++s) gwv[s] = *(const f32x4*)(p.gdn_nw + layer * 128 + s * 16 + 4 * g);
    for (int t = bid * 8 + wid; t < 4096 + 64; t += gridDim.x * 8) {
        int u, mt0; bool two;
        if (t < 4096) { u = t >> 1; mt0 = (t & 1) * 2; two = true; } else { u = 2048 + (t - 4096); mt0 = 0; two = false; }
        const int c = u >> 2, h = u & 3;
        int row0, nvalid;
        if (c < 512) { row0 = (c >> 8) * 16384 + (c & 255) * 64; nvalid = 64; } else { row0 = TP + (c - 512) * 16; nvalid = 16; }
        const unsigned char* frb = ws_fresh(p.ws) + OFF_FR + (size_t)u * FR_STRIDE;
        const u32x4* qgf = (const u32x4*)(frb + FR_QG) + lane;
        const u32x4* qkf = (const u32x4*)(frb + FR_QK) + lane;
        const unsigned char* svh = sv_home(p, u);
        const u32x4* sfr = (const u32x4*)svh + lane;
        const u32x4* vfr = (const u32x4*)(svh + 32768) + lane;
        u32x2 zv[2][8];
#pragma unroll
        for (int q = 0; q < 2; ++q) {
            const int r = (mt0 + q) * 16 + n;
            const size_t grow = (size_t)(row0 + ((r < nvalid && (q == 0 || two)) ? r : 0));
            const bf16_t* zr = pz + grow * 512 + h * 128 + 4 * g;
#pragma unroll
            for (int s = 0; s < 8; ++s) zv[q][s] = *(const u32x2*)(zr + s * 16);
        }
        bf16x8 qg[2][4], qk[2][2];
#pragma unroll
        for (int q = 0; q < 2; ++q) {
            const int mt = two ? mt0 + q : 0;
#pragma unroll
            for (int ks = 0; ks < 4; ++ks) qg[q][ks] = __builtin_bit_cast(bf16x8, qgf[(mt * 4 + ks) * 64]);
#pragma unroll
            for (int ks = 0; ks < 2; ++ks) qk[q][ks] = __builtin_bit_cast(bf16x8, qkf[(mt * 2 + ks) * 64]);
        }
        f32x4 o[2][8];
#pragma unroll
        for (int s = 0; s < 8; ++s) {
            bf16x8 sb[4], vb[2];
#pragma unroll
            for (int ks = 0; ks < 4; ++ks) sb[ks] = __builtin_bit_cast(bf16x8, sfr[(s * 4 + ks) * 64]);
#pragma unroll
            for (int ks = 0; ks < 2; ++ks) vb[ks] = __builtin_bit_cast(bf16x8, vfr[(s * 2 + ks) * 64]);
#pragma unroll
            for (int q = 0; q < 2; ++q) {
                f32x4 acc = {0.f, 0.f, 0.f, 0.f};
#pragma unroll
                for (int ks = 0; ks < 4; ++ks) acc = MFMA16(sb[ks], qg[q][ks], acc);
#pragma unroll
                for (int ks = 0; ks < 2; ++ks) acc = MFMA16(vb[ks], qk[q][ks], acc);
                o[q][s] = acc;
            }
        }
#pragma unroll
        for (int q = 0; q < 2; ++q) {
            float v = 0.f;
#pragma unroll
            for (int s = 0; s < 8; ++s) v += o[q][s][0] * o[q][s][0] + o[q][s][1] * o[q][s][1] + o[q][s][2] * o[q][s][2] + o[q][s][3] * o[q][s][3];
            v += __shfl_xor(v, 16); v += __shfl_xor(v, 32);
            const float rs = rsqrtf(v * (1.f / 128.f) + 1e-6f);
            const int r = (mt0 + q) * 16 + n;
            if (r < nvalid && (q == 0 || two)) {
                bf16_t* mr = mixin + (size_t)(row0 + r) * 1024 + h * 128 + 4 * g;
#pragma unroll
                for (int s = 0; s < 8; ++s) {
                    const float z0 = __uint_as_float(zv[q][s].x << 16), z1 = __uint_as_float(zv[q][s].x & 0xffff0000u), z2 = __uint_as_float(zv[q][s].y << 16), z3 = __uint_as_float(zv[q][s].y & 0xffff0000u);
                    const f32x4 ov = o[q][s] * rs * gwv[s];
                    u32x2 w; w.x = pk_bf16(ov[0] * silu_fast(z0), ov[1] * silu_fast(z1)); w.y = pk_bf16(ov[2] * silu_fast(z2), ov[3] * silu_fast(z3));
                    *(u32x2*)(mr + s * 16) = w;
                }
            }
        }
    }
}

#define XB_TMO      128
#define XB_XCNT(j)  (256  + 64 * (j))
#define XB_XSUB(j)  (1280 + 64 * (j))
#define XB_XGEN(j)  (2304 + 64 * (j))
#define XB_TOP      3328
#define XB_TOPGEN   3392
#define XCD_BAR_WORDS 3456
#define XB_SPIN_CAP (1u << 20)
DI unsigned xb_ld(unsigned* p)              { return __hip_atomic_load(p, __ATOMIC_RELAXED, __HIP_MEMORY_SCOPE_AGENT); }
DI unsigned xb_add(unsigned* p, unsigned v) { return __hip_atomic_fetch_add(p, v, __ATOMIC_RELAXED, __HIP_MEMORY_SCOPE_AGENT); }
DI unsigned xb_xcc_id() { return (unsigned)__builtin_amdgcn_s_getreg((3 << 11) | 20) & 0xFu; }
#define XB_SPIN(cond, bar) do { unsigned _sp = 0; while (cond) { __builtin_amdgcn_s_sleep(1); \
    if ((++_sp & 255u) == 0u) { if (xb_ld(&(bar)[XB_TMO])) break; if (_sp > XB_SPIN_CAP) { atomicAdd(&(bar)[XB_TMO], 1u); break; } } } } while (0)
struct XcdBarrier { unsigned* bar; unsigned x; volatile LAS unsigned* st; };
DI XcdBarrier xcd_barrier_post(unsigned* bar, volatile LAS unsigned* st) {
    XcdBarrier b; b.bar = bar; b.x = xb_xcc_id(); b.st = st;
    if (threadIdx.x == 0) (void)xb_add(&bar[XB_XCNT(b.x)], 1u);
    return b;
}
DI void xcd_barrier_complete(unsigned* bar, unsigned x, unsigned& nloc, unsigned& nx) {
    const unsigned G = gridDim.x * gridDim.y * gridDim.z;
    unsigned sum, cnt, mine, sp = 0u;
    for (;;) {
        sum = 0u; cnt = 0u; mine = 0u;
#pragma unroll
        for (unsigned j = 0; j < 16; ++j) { const unsigned c = xb_ld(&bar[XB_XCNT(j)]); sum += c; cnt += (c > 0u) ? 1u : 0u; mine = (j == x) ? c : mine; }
        if (sum == G) break;
        __builtin_amdgcn_s_sleep(1);
        if ((++sp & 255u) == 0u) { if (xb_ld(&bar[XB_TMO])) break; if (sp > XB_SPIN_CAP) { atomicAdd(&bar[XB_TMO], 1u); break; } }
    }
    nloc = mine > 0u ? mine : 1u; nx = cnt > 0u ? cnt : 1u;
}
DI void xcd_barrier(const XcdBarrier& b) {
    asm volatile("s_waitcnt vmcnt(0)" ::: "memory");
    __syncthreads();
    if (threadIdx.x == 0) {
        unsigned* bar = b.bar;
        asm volatile("" : "+s"(bar));
        __builtin_amdgcn_s_waitcnt(0);
        unsigned nloc = b.st[0], nx = b.st[1];
        if (nloc == 0u) { xcd_barrier_complete(bar, b.x, nloc, nx); b.st[0] = nloc; b.st[1] = nx; }
        const unsigned old = xb_add(&bar[XB_XSUB(b.x)], 1u);
        const unsigned gen = old / nloc;
        if (old + 1u == (gen + 1u) * nloc) {
            __builtin_amdgcn_fence(__ATOMIC_RELEASE, "agent");
            asm volatile("s_waitcnt vmcnt(0)" ::: "memory");
            const unsigned og = xb_add(&bar[XB_TOP], 1u);
            const unsigned tg = og / nx;
            if (og + 1u == (tg + 1u) * nx) xb_add(&bar[XB_TOPGEN], 1u);
            else XB_SPIN(xb_ld(&bar[XB_TOPGEN]) == tg, bar);
            __builtin_amdgcn_fence(__ATOMIC_ACQUIRE, "agent");
            xb_add(&bar[XB_XGEN(b.x)], 1u);
            asm volatile("s_waitcnt vmcnt(0)" ::: "memory");
        } else {
            XB_SPIN(xb_ld(&bar[XB_XGEN(b.x)]) == gen, bar);
            __builtin_amdgcn_fence(__ATOMIC_ACQUIRE, "agent");
            asm volatile("s_waitcnt vmcnt(0)" ::: "memory");
        }
    }
    __syncthreads();
}

__global__ void __launch_bounds__(512) mega(Params p) {
    extern __shared__ __attribute__((aligned(16))) unsigned char smem[];
    cg::grid_group grid = cg::this_grid();
    LAS unsigned char* lds = (LAS unsigned char*)smem;
    volatile LAS unsigned* xst = (volatile LAS unsigned*)(lds + LDS_BYTES - 16);
    if (threadIdx.x == 0) { xst[0] = 0u; xst[1] = 0u; }
    __syncthreads();
    const XcdBarrier xb = xcd_barrier_post((unsigned*)(ws_fresh(p.ws) + OFF_BAR), xst);

    phase_weights(p, smem);
    row_phase<0>(p, 0, 0, smem);
    if (p.ws == nullptr) grid.sync();
    xcd_barrier(xb);
    for (int l = 0; l < 2; ++l) {
        {
            pg8::Gemm g{(const bf16_t*)(ws_fresh(p.ws) + OFF_XB), (const bf16_t*)(ws_fresh(p.ws) + OFF_WIN + l * SZ_WIN), TT, 3584, 1024};
            pg8::StaticOrder S; S.init(TT, 3584, 1024, gridDim.x, bid_fresh());
            EpiG1 e{(const float*)(ws_fresh(p.ws) + OFF_RSTD), (bf16_t*)(ws_fresh(p.ws) + OFF_PQKV), (bf16_t*)(ws_fresh(p.ws) + OFF_PSC), (bf16_t*)(ws_fresh(p.ws) + OFF_PZ)};
            pg8::gemm_phase(lds, g, S, e);
        }
        xcd_barrier(xb);
        phase_chunk_scan(p, l, smem, lds);
        xcd_barrier(xb);
        phase_out(p, l);
        xcd_barrier(xb);
        {
            pg8::Gemm g{(const bf16_t*)(p.out + O_Y), (const bf16_t*)(ws_fresh(p.ws) + OFF_WO + l * SZ_WO), TT, 1024, 1024};
            pg8::SplitOrder S; S.init(1024, 1024, gridDim.x, bid_fresh());
            EpiRawSplit e{(bf16_t*)(ws_fresh(p.ws) + OFF_RAW), (float*)(ws_fresh(p.ws) + OFF_PZ)};
            pg8::gemm_phase(lds, g, S, e);
        }
        xcd_barrier(xb);
        row_phase<1>(p, l, 0, smem);
        xcd_barrier(xb);
        {
            pg8::Gemm g{(const bf16_t*)(ws_fresh(p.ws) + OFF_XB), (const bf16_t*)(ws_fresh(p.ws) + OFF_WGU + l * SZ_WGU), TT, 5632, 1024};
            pg8::StaticOrder S; S.init(TT, 5632, 1024, gridDim.x, bid_fresh());
            EpiGU e{(const float*)(ws_fresh(p.ws) + OFF_RSTD), (bf16_t*)(ws_fresh(p.ws) + OFF_ACT)};
            pg8::gemm_phase(lds, g, S, e);
        }
        xcd_barrier(xb);
        {
            pg8::Gemm g{(const bf16_t*)(ws_fresh(p.ws) + OFF_ACT), (const bf16_t*)(ws_fresh(p.ws) + OFF_WD + l * SZ_WD), TT, 1024, DFF};
            pg8::SplitOrder S; S.init(1024, DFF, gridDim.x, bid_fresh());
            EpiRawSplit e{(bf16_t*)(ws_fresh(p.ws) + OFF_RAW), (float*)(ws_fresh(p.ws) + OFF_PZ)};
            pg8::gemm_phase(lds, g, S, e);
        }
        xcd_barrier(xb);
        if (l == 0) { row_phase<2>(p, 0, 1, smem); xcd_barrier(xb); }
        else row_phase<3>(p, 1, 0, smem);
    }
}

extern "C" void kernel_launch(void* const* d_in, const int* in_sizes, int n_in, void* d_out, int out_size, void* d_ws, size_t ws_size,
                              hipStream_t stream) {
    static int grid_blocks = 0;
    if (!grid_blocks) {
        int dev = 0, cus = 0, per_cu = 0;
        hipGetDevice(&dev);
        hipDeviceGetAttribute(&cus, hipDeviceAttributeMultiprocessorCount, dev);
        hipFuncSetAttribute((const void*)mega, hipFuncAttributeMaxDynamicSharedMemorySize, LDS_BYTES);
        hipOccupancyMaxActiveBlocksPerMultiprocessor(&per_cu, mega, 512, LDS_BYTES);
        if (per_cu > 1) per_cu = 1;
        grid_blocks = cus * per_cu;
        if (grid_blocks < 128) { fprintf(stderr, "unexpected occupancy: cus=%d per_cu=%d\n", cus, per_cu); }
    }
    if (ws_size < WS_NEED) { fprintf(stderr, "workspace too small: %zu < %zu\n", ws_size, (size_t)WS_NEED); return; }
    Params p{};
    const float* const* in = (const float* const*)d_in;
    p.xp = in[0]; p.xs = in[1]; p.cache_conv = in[2]; p.state0 = in[3]; p.cache_sc = in[4]; p.n_mix_pre = in[5]; p.w_in = in[6];
    p.conv_w = in[7]; p.a_log = in[8]; p.dt_bias = in[9]; p.gdn_nw = in[10]; p.conv_sc_w = in[11]; p.w_o = in[12]; p.n_mix_post = in[13];
    p.n_ffn_pre = in[14]; p.w_gate = in[15]; p.w_up = in[16]; p.w_down = in[17]; p.n_ffn_post = in[18];
    p.out = (float*)d_out; p.ws = (unsigned char*)d_ws;
    hipMemsetAsync((unsigned char*)d_ws + OFF_BAR, 0, 32768, stream);
    void* args[] = {&p};
    hipError_t e = hipLaunchCooperativeKernel((const void*)mega, dim3(grid_blocks), dim3(512), args, LDS_BYTES, stream);
    if (e != hipSuccess) fprintf(stderr, "cooperative launch failed: %s (grid %d)\n", hipGetErrorString(e), grid_blocks);
}
```

```cpp
#include <hip/hip_runtime.h>
#include <hip/hip_cooperative_groups.h>
#include <cstdio>
namespace cg = cooperative_groups;

#define LAS __attribute__((address_space(3)))
typedef unsigned short bf16_t;
typedef short bf16x8 __attribute__((ext_vector_type(8)));
typedef float f32x4 __attribute__((ext_vector_type(4)));
typedef float f32x2 __attribute__((ext_vector_type(2)));
typedef unsigned u32x4 __attribute__((ext_vector_type(4)));
typedef unsigned u32x2 __attribute__((ext_vector_type(2)));
typedef __bf16 bf16v2 __attribute__((ext_vector_type(2)));
#define DI __device__ __forceinline__
DI int tid_fresh() { int t = threadIdx.x; asm volatile("" : "+v"(t)); return t; }
DI int bid_fresh() { int b = blockIdx.x; asm volatile("" : "+s"(b)); return b; }
DI unsigned char* ws_fresh(unsigned char* w) { asm volatile("" : "+s"(w)); return w; }

constexpr int DM = 1024, TT = 33024, TP = 32768, DFF = 2816, INDIM = 3592;
constexpr int NCHH = 2112;
constexpr int LDS_BYTES = 147456;

constexpr size_t SZ_WIN = (size_t)3584 * 1024 * 2, SZ_WO = (size_t)1024 * 1024 * 2, SZ_WGU = (size_t)5632 * 1024 * 2, SZ_WD = (size_t)1024 * 2816 * 2;
constexpr size_t OFF_WIN = 0;
constexpr size_t OFF_WO = OFF_WIN + 2 * SZ_WIN;
constexpr size_t OFF_WGU = OFF_WO + 2 * SZ_WO;
constexpr size_t OFF_WD = OFF_WGU + 2 * SZ_WGU;
constexpr size_t OFF_WBA = OFF_WD + 2 * SZ_WD;
constexpr size_t OFF_RSTD = OFF_WBA + 2 * 8 * 1024 * 4;
constexpr size_t OFF_BETA = OFF_RSTD + (size_t)TT * 4;
constexpr size_t OFF_GLOG = OFF_BETA + (size_t)TT * 16;
constexpr size_t OFF_AL = OFF_GLOG + (size_t)TT * 16;
constexpr size_t OFF_BAR = OFF_AL + 16384;
constexpr size_t OFF_FLAG = OFF_BAR + 16384;
constexpr size_t OFF_SPARE = OFF_FLAG + 16384;
constexpr size_t OFF_XB = OFF_SPARE + (size_t)18 * 196608;
constexpr size_t OFF_PQKV = OFF_XB + (size_t)TT * 1024 * 2;
constexpr size_t OFF_PSC = OFF_PQKV + (size_t)TT * 1536 * 2;
constexpr size_t OFF_PZ = OFF_PSC + (size_t)TT * 1536 * 2;
constexpr size_t OFF_ACT = OFF_PQKV;
constexpr size_t OFF_FR = OFF_PZ + (size_t)TT * 512 * 2;
constexpr size_t FR_STRIDE = 74752, FR_W = 0, FR_KT = 16384, FR_QG = 32768, FR_QK = 49152, FR_U = 57344, FR_META = 73728;
constexpr size_t OFF_RAW = OFF_FR;
constexpr size_t WS_NEED = OFF_FR + (size_t)NCHH * FR_STRIDE;
static_assert((size_t)TT * 1024 * 4 <= (size_t)NCHH * FR_STRIDE, "raw fits");
static_assert(WS_NEED <= (size_t)536870912, "workspace");

constexpr size_t O_Y = 0;
constexpr size_t O_CONVP = (size_t)TT * 1024;
constexpr size_t O_STP = O_CONVP + 2 * 2 * 3 * 1536;
constexpr size_t O_SCP = O_STP + (size_t)2 * 2 * 4 * 16384;
constexpr size_t O_CONVS = O_SCP + 2 * 2 * 2 * 512;
constexpr size_t O_STS = O_CONVS + (size_t)2 * 16 * 3 * 1536;
constexpr size_t O_SCS = O_STS + (size_t)2 * 16 * 4 * 16384;

struct Params {
    const float *xp, *xs, *cache_conv, *state0, *cache_sc, *n_mix_pre, *w_in, *conv_w, *a_log, *dt_bias, *gdn_nw, *conv_sc_w, *w_o,
        *n_mix_post, *n_ffn_pre, *w_gate, *w_up, *w_down, *n_ffn_post;
    float* out;
    unsigned char* ws;
};

DI float bf2f(bf16_t v) { return __uint_as_float(((unsigned)v) << 16); }
DI unsigned pk_bf16(float lo, float hi) {
    f32x2 v = {lo, hi};
    bf16v2 r = __builtin_convertvector(v, bf16v2);
    return __builtin_bit_cast(unsigned, r);
}
DI bf16_t f2bf(float x) { return (bf16_t)(pk_bf16(x, 0.f) & 0xffffu); }
DI float silu_f(float x) { return x / (1.f + __expf(-x)); }
DI float wave_sum(float v) {
    v += __builtin_bit_cast(float, __builtin_amdgcn_update_dpp(0, __builtin_bit_cast(int, v), 0xB1, 0xf, 0xf, true));
    v += __builtin_bit_cast(float, __builtin_amdgcn_update_dpp(0, __builtin_bit_cast(int, v), 0x4E, 0xf, 0xf, true));
    v += __builtin_bit_cast(float, __builtin_amdgcn_update_dpp(0, __builtin_bit_cast(int, v), 0x141, 0xf, 0xf, true));
    v += __builtin_bit_cast(float, __builtin_amdgcn_update_dpp(0, __builtin_bit_cast(int, v), 0x140, 0xf, 0xf, true));
    v += __builtin_bit_cast(float, __builtin_amdgcn_update_dpp(0, __builtin_bit_cast(int, v), 0x142, 0xa, 0xf, false));
    v += __builtin_bit_cast(float, __builtin_amdgcn_update_dpp(0, __builtin_bit_cast(int, v), 0x143, 0xc, 0xf, false));
    return __builtin_bit_cast(float, __builtin_amdgcn_readlane(__builtin_bit_cast(int, v), 63));
}
DI bf16x8 pack8(const f32x4& a, const f32x4& b) {
    u32x4 p; p.x = pk_bf16(a[0], a[1]); p.y = pk_bf16(a[2], a[3]); p.z = pk_bf16(b[0], b[1]); p.w = pk_bf16(b[2], b[3]);
    return __builtin_bit_cast(bf16x8, p);
}

DI unsigned char* sv_home(const Params& p, int u) {
    const int c = u >> 2, h = u & 3;
    if (c < 512) {
        const int n = c & 255, b = c >> 8;
        if (n > 0) return ws_fresh(p.ws) + OFF_PQKV + (size_t)(b * 16384 + (n - 1) * 64) * 3072 + (size_t)h * 49152;
        return ws_fresh(p.ws) + OFF_SPARE + (size_t)b * 196608 + (size_t)h * 49152;
    }
    return ws_fresh(p.ws) + OFF_SPARE + (size_t)(2 + c - 512) * 196608 + (size_t)h * 49152;
}
DI void wait_count(unsigned* f, unsigned need) {
    unsigned sp = 0;
    while (__hip_atomic_load(f, __ATOMIC_RELAXED, __HIP_MEMORY_SCOPE_AGENT) < need) { __builtin_amdgcn_s_sleep(2); if (++sp > (1u << 22)) break; }
    __builtin_amdgcn_fence(__ATOMIC_ACQUIRE, "agent");
    asm volatile("s_waitcnt vmcnt(0)" ::: "memory");
}
DI void wait_counts8(unsigned* f, int first, int last_valid, int lane, unsigned need) {
    int idx = first + (lane & 7); if (idx > last_valid) idx = last_valid;
    unsigned sp = 0;
    for (;;) {
        const unsigned v = __hip_atomic_load(f + idx, __ATOMIC_RELAXED, __HIP_MEMORY_SCOPE_AGENT);
        if (__all(v >= need)) break;
        __builtin_amdgcn_s_sleep(2);
        if (++sp > (1u << 22)) break;
    }
    __builtin_amdgcn_fence(__ATOMIC_ACQUIRE, "agent");
    asm volatile("s_waitcnt vmcnt(0)" ::: "memory");
}
#define MFMA16(a, b, c) __builtin_amdgcn_mfma_f32_16x16x32_bf16((a), (b), (c), 0, 0, 0)

namespace pg8 {
constexpr int BM = 256, BK = 64, HALF = 128, HTB = HALF * BK * 2, STAGE_BYTES = 8 * HTB, NXCD = 8, WGM = 8;
DI int lds_byte(int r, int c) { const int st = (r >> 4) * 2 + (c >> 5), rr = r & 15, cc = c & 31, ob = rr * 64 + cc * 2; return st * 1024 + (ob ^ (((ob >> 9) & 1) << 5)); }
DI void stage_rc(int b, int& R, int& C) { const int st = b / 1024, sb = b % 1024, swz = sb ^ (((sb >> 9) & 1) << 5); R = (st >> 1) * 16 + swz / 64; C = (st & 1) * 32 + (swz % 64) / 2; }
DI int perm32(int rho) { const int n = rho >> 4, i = rho & 15; return 8 * (i >> 2) + 4 * n + (i & 3); }
struct Unit { int pm, pn, nt; unsigned kofs; };
struct Gemm { const bf16_t* A; const bf16_t* Bt; int M, N, K; };
struct StaticOrder {
    int nM, nN, nwg, G, c, ntf;
    DI void init(int M, int N, int K, int G_, int c_) { nM = M / BM; nN = N / BM; nwg = nM * nN; G = G_; c = c_; ntf = K / BK; }
    DI void map(int wgid, Unit& u) const {
        { const int q = nwg / NXCD, r = nwg % NXCD, xcd = wgid % NXCD, off = wgid / NXCD; wgid = (xcd < r ? xcd * (q + 1) : r * (q + 1) + (xcd - r) * q) + off; }
        const int nig = WGM * nN, gid = wgid / nig, fm = gid * WGM, gsz = (nM - fm) < WGM ? (nM - fm) : WGM;
        u.pm = fm + ((wgid % nig) % gsz); u.pn = (wgid % nig) / gsz; u.nt = ntf; u.kofs = 0u;
    }
    DI bool next(int i, Unit& u) const {
        const long L = (long)i * G + c; if (L >= nwg) return false;
        map((int)L, u); return true;
    }
};
struct SplitOrder : StaticOrder {
    int nsub;
    DI void init(int N, int K, int G_, int c_) { StaticOrder::init(TP, N, K, G_, c_); nsub = nN * (K / 256); }
    DI bool next(int i, Unit& u) const {
        const long L = (long)i * G + c;
        if (L < nwg) { map((int)L, u); return true; }
        const int j = (int)(L - nwg); if (j >= nsub) return false;
        u.pm = 128; u.pn = j % nN; u.nt = 4; u.kofs = (unsigned)(j / nN) * 512u; return true;
    }
};
template <class Epi, class Sched, bool ALIGN_EPI = true>
DI void gemm_phase(LAS unsigned char* lds, const Gemm g, const Sched& S, const Epi& E) {
    const int tid = tid_fresh(), wid = __builtin_amdgcn_readfirstlane(tid >> 6), lane = tid & 63, wr = wid >> 2, wc = wid & 3, fr = lane & 15, fq = lane >> 4;
    const int K = g.K;
    unsigned voffA[2], voffB[2];
#pragma unroll
    for (int i = 0; i < 2; ++i) { int R, C; stage_rc(tid * 16 + i * 8192, R, C); const int Rb = ((R & ~31) + perm32(R & 31));
        voffA[i] = (unsigned)(R * K + C) * 2u; voffB[i] = (unsigned)(Rb * K + C) * 2u; }
    const size_t kstep = (size_t)(BK * 2);
    const size_t hstep = (size_t)HALF * K * 2;
    const size_t tstep = 2 * hstep;
    const unsigned ldsw = (unsigned)wid * 1024u;
    const int aoff = lds_byte(wr * 64 + fr, fq * 8), boff = lds_byte(wc * 32 + fr, fq * 8);
#define PG8_SA(b, h) (((b) * 2 + (h)) * HTB)
#define PG8_SB(b, h) ((4 + (b) * 2 + (h)) * HTB)
#define PG8_STAGE(bufoff, gbase, voff) do { _Pragma("unroll") for (int _i = 0; _i < 2; ++_i) \
        __builtin_amdgcn_global_load_lds((const unsigned*)((const char*)(gbase) + (voff)[_i]), (LAS unsigned*)(lds + (bufoff) + ldsw + _i * 8192), 16, 0, 0); } while (0)
#define PG8_LDA(dst, b, h) do { _Pragma("unroll") for (int m = 0; m < 4; ++m) _Pragma("unroll") for (int k = 0; k < 2; ++k) dst[m][k] = *(const LAS bf16x8*)(lds + PG8_SA(b, h) + aoff + m * 2048 + k * 1024); } while (0)
#define PG8_LDB(dst, b, h) do { _Pragma("unroll") for (int n = 0; n < 2; ++n) _Pragma("unroll") for (int k = 0; k < 2; ++k) dst[n][k] = *(const LAS bf16x8*)(lds + PG8_SB(b, h) + boff + n * 2048 + k * 1024); } while (0)
#define PG8_MMA(ai, bj, At, Bt) do { __builtin_amdgcn_s_setprio(1); _Pragma("unroll") for (int m = 0; m < 4; ++m) _Pragma("unroll") for (int n = 0; n < 2; ++n) _Pragma("unroll") for (int k = 0; k < 2; ++k) \
        acc[ai][bj][m][n] = __builtin_amdgcn_mfma_f32_16x16x32_bf16(Bt[n][k], At[m][k], acc[ai][bj][m][n], 0, 0, 0); __builtin_amdgcn_s_setprio(0); } while (0)
#define PG8_WAIT_V(n) asm volatile("s_waitcnt vmcnt(" #n ")" ::: "memory")
#define PG8_WAIT_L(n) asm volatile("s_waitcnt lgkmcnt(" #n ")" ::: "memory")
#define PG8_BAR __builtin_amdgcn_s_barrier()
#define PG8_SCHED __builtin_amdgcn_sched_barrier(0)
    Unit cur, nxt; int ui = 0;
    if (!S.next(0, cur)) return;
    f32x4 acc[2][2][4][2];
#pragma unroll
    for (int a = 0; a < 2; ++a)
#pragma unroll
        for (int b = 0; b < 2; ++b)
#pragma unroll
            for (int m = 0; m < 4; ++m)
#pragma unroll
                for (int n = 0; n < 2; ++n) acc[a][b][m][n] = (f32x4){0.f, 0.f, 0.f, 0.f};
    bf16x8 At[4][2], B0[2][2], B1[2][2];
    const char* cA = (const char*)g.A + (size_t)cur.pm * tstep + cur.kofs; const char* cB = (const char*)g.Bt + (size_t)cur.pn * tstep + cur.kofs;
    PG8_STAGE(PG8_SB(0, 0), cB, voffB); PG8_STAGE(PG8_SB(0, 1), cB + hstep, voffB); PG8_STAGE(PG8_SA(0, 0), cA, voffA); PG8_STAGE(PG8_SA(0, 1), cA + hstep, voffA);
    if (wr == 1) PG8_BAR;
    PG8_WAIT_V(2); PG8_BAR;
    PG8_STAGE(PG8_SB(1, 0), cB + kstep, voffB); PG8_STAGE(PG8_SA(1, 0), cA + kstep, voffA); PG8_STAGE(PG8_SB(1, 1), cB + hstep + kstep, voffB);
    PG8_WAIT_V(6); PG8_BAR;
    for (;;) {
        const bool has_next = S.next(ui + 1, nxt);
        const char* nA = has_next ? (const char*)g.A + (size_t)nxt.pm * tstep + nxt.kofs : cA; const char* nB = has_next ? (const char*)g.Bt + (size_t)nxt.pn * tstep + nxt.kofs : cB;
        const int nt = cur.nt;
        for (int t = 0; t < nt; t += 2) {
            const bool last = (t == nt - 2);
            const char* a1 = cA + (size_t)(t + 1) * kstep;
            const char* a2 = last ? nA : cA + (size_t)(t + 2) * kstep; const char* b2 = last ? nB : cB + (size_t)(t + 2) * kstep;
            const char* a3 = a2 + kstep; const char* b3 = b2 + kstep;
            PG8_LDB(B0, 0, 0); PG8_LDB(B1, 0, 1); PG8_SCHED; PG8_LDA(At, 0, 0); PG8_STAGE(PG8_SA(1, 1), a1 + hstep, voffA);
            PG8_WAIT_V(8); PG8_WAIT_L(0); PG8_BAR; PG8_MMA(0, 0, At, B0); PG8_MMA(0, 1, At, B1); PG8_BAR; PG8_SCHED;
            PG8_LDA(At, 0, 1); PG8_STAGE(PG8_SB(0, 0), b2, voffB); PG8_STAGE(PG8_SB(0, 1), b2 + hstep, voffB); PG8_STAGE(PG8_SA(0, 0), a2, voffA);
            PG8_WAIT_V(8); PG8_WAIT_L(0); PG8_BAR; PG8_MMA(1, 0, At, B0); PG8_MMA(1, 1, At, B1); PG8_BAR; PG8_SCHED;
            PG8_LDB(B0, 1, 0); PG8_LDB(B1, 1, 1); PG8_SCHED; PG8_LDA(At, 1, 0); PG8_STAGE(PG8_SA(0, 1), a2 + hstep, voffA);
            PG8_WAIT_V(8); PG8_WAIT_L(0); PG8_BAR; PG8_MMA(0, 0, At, B0); PG8_MMA(0, 1, At, B1); PG8_BAR; PG8_SCHED;
            PG8_LDA(At, 1, 1); PG8_STAGE(PG8_SB(1, 0), b3, voffB); PG8_STAGE(PG8_SB(1, 1), b3 + hstep, voffB); PG8_STAGE(PG8_SA(1, 0), a3, voffA);
            PG8_WAIT_V(8); PG8_WAIT_L(0); PG8_BAR; PG8_MMA(1, 0, At, B0); PG8_MMA(1, 1, At, B1); PG8_BAR; PG8_SCHED;
        }
        if constexpr (ALIGN_EPI) { if (wr == 0) PG8_BAR; }
        E(acc, cur, wr, wc, fr, fq);
        if (!has_next) break;
#pragma unroll
        for (int a = 0; a < 2; ++a)
#pragma unroll
            for (int b = 0; b < 2; ++b)
#pragma unroll
                for (int m = 0; m < 4; ++m)
#pragma unroll
                    for (int n = 0; n < 2; ++n) acc[a][b][m][n] = (f32x4){0.f, 0.f, 0.f, 0.f};
        cur = nxt; cA = nA; cB = nB; ++ui;
        if constexpr (ALIGN_EPI) { if (wr == 1) PG8_BAR; }
    }
    PG8_WAIT_V(0);
    if constexpr (!ALIGN_EPI) { if (wr == 0) PG8_BAR; }
    PG8_BAR;
#undef PG8_SA
#undef PG8_SB
#undef PG8_STAGE
#undef PG8_LDA
#undef PG8_LDB
#undef PG8_MMA
#undef PG8_WAIT_V
#undef PG8_WAIT_L
#undef PG8_BAR
#undef PG8_SCHED
}
}

using pg8::Unit;
typedef f32x4 AccT[2][2][4][2];

struct EpiG1 {
    const float* rstd; bf16_t *pqkv, *psc, *pz;
    DI void operator()(const AccT& acc, const Unit& u, int wr, int wc, int fr, int fq) const {
        bf16_t* base; int ldc, colt;
        if (u.pn < 6) { base = pqkv; ldc = 1536; colt = u.pn * 256; }
        else if (u.pn < 8) { base = pz; ldc = 512; colt = (u.pn - 6) * 256; }
        else { base = psc; ldc = 1536; colt = (u.pn - 8) * 256; }
        const int row0 = u.pm * 256 + wr * 64 + fr, col0 = colt + wc * 32 + 8 * fq;
#pragma unroll
        for (int ai = 0; ai < 2; ++ai)
#pragma unroll
            for (int m = 0; m < 4; ++m) {
                const int row = row0 + ai * 128 + m * 16;
                bf16_t* rowp = base + (size_t)row * ldc + col0;
#pragma unroll
                for (int bj = 0; bj < 2; ++bj) {
                    const f32x4 v0 = acc[ai][bj][m][0], v1 = acc[ai][bj][m][1];
                    u32x4 w; w.x = pk_bf16(v0[0], v0[1]); w.y = pk_bf16(v0[2], v0[3]); w.z = pk_bf16(v1[0], v1[1]); w.w = pk_bf16(v1[2], v1[3]);
                    *(u32x4*)(rowp + bj * 128) = w;
                }
            }
    }
};
struct EpiRawSplit {
    bf16_t* C; float* racc;
    DI void operator()(const AccT& acc, const Unit& u, int wr, int wc, int fr, int fq) const {
        const int row0 = u.pm * 256 + wr * 64 + fr, col0 = u.pn * 256 + wc * 32 + 8 * fq;
        if (u.pm < 128) {
#pragma unroll
            for (int ai = 0; ai < 2; ++ai)
#pragma unroll
                for (int m = 0; m < 4; ++m) {
                    bf16_t* rowp = C + (size_t)(row0 + ai * 128 + m * 16) * 1024 + col0;
#pragma unroll
                    for (int bj = 0; bj < 2; ++bj) {
                        const f32x4 v0 = acc[ai][bj][m][0], v1 = acc[ai][bj][m][1];
                        u32x4 w; w.x = pk_bf16(v0[0], v0[1]); w.y = pk_bf16(v0[2], v0[3]); w.z = pk_bf16(v1[0], v1[1]); w.w = pk_bf16(v1[2], v1[3]);
                        *(u32x4*)(rowp + bj * 128) = w;
                    }
                }
        } else {
#pragma unroll
            for (int ai = 0; ai < 2; ++ai)
#pragma unroll
                for (int m = 0; m < 4; ++m) {
                    float* rowp = racc + (size_t)(u.kofs >> 9) * 262144 + (size_t)(row0 - TP + ai * 128 + m * 16) * 1024 + col0;
#pragma unroll
                    for (int bj = 0; bj < 2; ++bj) { *(f32x4*)(rowp + bj * 128) = acc[ai][bj][m][0]; *(f32x4*)(rowp + bj * 128 + 4) = acc[ai][bj][m][1]; }
                }
        }
    }
};
struct EpiGU {
    const float* rstd; bf16_t* act;
    DI void operator()(const AccT& acc, const Unit& u, int wr, int wc, int fr, int fq) const {
        const int row0 = u.pm * 256 + wr * 64 + fr, col0 = u.pn * 128 + wc * 32 + 8 * fq;
#pragma unroll
        for (int ai = 0; ai < 2; ++ai)
#pragma unroll
            for (int m = 0; m < 4; ++m) {
                const int row = row0 + ai * 128 + m * 16;
                float o[8];
#pragma unroll
                for (int n = 0; n < 2; ++n)
#pragma unroll
                    for (int i = 0; i < 4; ++i) { const float gv = acc[ai][0][m][n][i], uv = acc[ai][1][m][n][i]; o[n * 4 + i] = gv * __builtin_amdgcn_rcpf(1.f + __expf(-gv)) * uv; }
                u32x4 w; w.x = pk_bf16(o[0], o[1]); w.y = pk_bf16(o[2], o[3]); w.z = pk_bf16(o[4], o[5]); w.w = pk_bf16(o[6], o[7]);
                *(u32x4*)(act + (size_t)row * DFF + col0) = w;
            }
    }
};

DI void wtile(const float* src, int ld, int k0, int n0, const float* gain, bf16_t* dst, int K, int nd0, unsigned char* smem) {
    bf16_t* tl = (bf16_t*)smem;
    const int tid = tid_fresh();
    {
        const int kk = tid >> 2, cs = (tid & 3) * 16;
        const float gsc = gain ? gain[k0 + kk] : 1.f;
        const float* sp = src + (size_t)(k0 + kk) * ld + n0 + cs;
        f32x4 v[4];
#pragma unroll
        for (int q = 0; q < 4; ++q) v[q] = *(const f32x4*)(sp + 4 * q);
#pragma unroll
        for (int q = 0; q < 4; ++q)
#pragma unroll
            for (int i = 0; i < 4; ++i) tl[(cs + 4 * q + i) * 136 + kk] = f2bf(v[q][i] * gsc);
    }
    __syncthreads();
    {
        const int n = tid >> 3, ks = (tid & 7) * 16;
        const u32x4 v0 = *(const u32x4*)(tl + n * 136 + ks), v1 = *(const u32x4*)(tl + n * 136 + ks + 8);
        bf16_t* dp = dst + (size_t)(nd0 + n) * K + k0 + ks;
        *(u32x4*)dp = v0; *(u32x4*)(dp + 8) = v1;
    }
    __syncthreads();
}
DI void phase_weights(const Params& p, unsigned char* smem) {
    constexpr int PER = 448 + 128 + 704 + 352;
    const int bid = bid_fresh();
    for (int j = bid; j < 2 * PER; j += gridDim.x) {
        const int l = j / PER; int r = j % PER;
        if (r < 448) {
            const int kt = r / 56, nt = r % 56, nd0 = nt * 64, n0 = nd0 < 2048 ? nd0 : nd0 + 8;
            wtile(p.w_in + (size_t)l * 1024 * INDIM, INDIM, kt * 128, n0, p.n_mix_pre + l * 1024, (bf16_t*)(ws_fresh(p.ws) + OFF_WIN + l * SZ_WIN), 1024, nd0, smem);
        } else if (r < 448 + 128) {
            r -= 448; const int kt = r / 16, nt = r % 16;
            wtile(p.w_o + (size_t)l * 1024 * 1024, 1024, kt * 128, nt * 64, nullptr, (bf16_t*)(ws_fresh(p.ws) + OFF_WO + l * SZ_WO), 1024, nt * 64, smem);
        } else if (r < 448 + 128 + 704) {
            r -= 448 + 128; const int kt = r / 88, nt = r % 88, nd0 = nt * 64, pp = nd0 / 256, s = (nd0 % 256) / 128, jj = nd0 % 128;
            const float* src = (s ? p.w_up : p.w_gate) + (size_t)l * 1024 * DFF;
            wtile(src, DFF, kt * 128, pp * 128 + jj, p.n_ffn_pre + l * 1024, (bf16_t*)(ws_fresh(p.ws) + OFF_WGU + l * SZ_WGU), 1024, nd0, smem);
        } else {
            r -= 448 + 128 + 704; const int kt = r / 16, nt = r % 16;
            wtile(p.w_down + (size_t)l * DFF * 1024, 1024, kt * 128, nt * 64, nullptr, (bf16_t*)(ws_fresh(p.ws) + OFF_WD + l * SZ_WD), DFF, nt * 64, smem);
        }
    }
}

template <int MODE>
DI void row_phase(const Params& p, int layer, int lnext, unsigned char* smem) {
    const int tid = tid_fresh(), wid = tid >> 6, lane = tid & 63, bid = bid_fresh();
    float* wl = (float*)smem;
    if (MODE == 0 || MODE == 2) {
        for (int i = tid; i < 8192; i += 512) {
            const int k = i >> 3, j = i & 7;
            wl[j * 1024 + k] = p.n_mix_pre[lnext * 1024 + k] * p.w_in[((size_t)lnext * 1024 + k) * INDIM + 2048 + j];
        }
        __syncthreads();
    }
    const bf16_t* raw = (const bf16_t*)(ws_fresh(p.ws) + OFF_RAW);
    bf16_t* xa = (bf16_t*)(ws_fresh(p.ws) + OFF_XB);
    float* rstd = (float*)(ws_fresh(p.ws) + OFF_RSTD);
    const float* gain = MODE == 1 ? p.n_mix_post + layer * 1024 : p.n_ffn_post + layer * 1024;
    f32x4 gn[4];
    if (MODE != 0) {
#pragma unroll
        for (int hh = 0; hh < 2; ++hh) { gn[2 * hh] = *(const f32x4*)(gain + hh * 512 + lane * 8); gn[2 * hh + 1] = *(const f32x4*)(gain + hh * 512 + lane * 8 + 4); }
    }
    constexpr int NR = 2;
    const int gw = bid * 8 + wid, nw = gridDim.x * 8;
    for (int rb = gw * NR; rb < TT; rb += nw * NR) {
        f32x4 x[NR][4];
        u32x4 rw[NR][2];
#pragma unroll
        for (int q = 0; q < NR; ++q) {
            const int r = rb + q;
            if (MODE == 0) {
                const float* res = r < TP ? p.xp + (size_t)r * 1024 : p.xs + (size_t)(r - TP) * 1024;
#pragma unroll
                for (int hh = 0; hh < 2; ++hh) { x[q][2 * hh] = *(const f32x4*)(res + hh * 512 + lane * 8); x[q][2 * hh + 1] = *(const f32x4*)(res + hh * 512 + lane * 8 + 4); }
            } else {
#pragma unroll
                for (int hh = 0; hh < 2; ++hh) {
                    const u32x4 v = *(const u32x4*)(xa + (size_t)r * 1024 + hh * 512 + lane * 8);
                    const float inv = 1.f / rstd[r];
                    x[q][2 * hh] = (f32x4){__uint_as_float(v.x << 16), __uint_as_float(v.x & 0xffff0000u), __uint_as_float(v.y << 16), __uint_as_float(v.y & 0xffff0000u)} * inv;
                    x[q][2 * hh + 1] = (f32x4){__uint_as_float(v.z << 16), __uint_as_float(v.z & 0xffff0000u), __uint_as_float(v.w << 16), __uint_as_float(v.w & 0xffff0000u)} * inv;
                    rw[q][hh] = __builtin_nontemporal_load((const u32x4*)(raw + (size_t)r * 1024 + hh * 512 + lane * 8));
                }
            }
        }
#pragma unroll
        for (int q = 0; q < NR; ++q) {
            const int r = rb + q;
            if (MODE != 0) {
                f32x4 f[4];
                if (rb >= TP) {
                    const float* ra = (const float*)(ws_fresh(p.ws) + OFF_PZ) + (size_t)(r - TP) * 1024 + lane * 8;
#pragma unroll
                    for (int i = 0; i < 4; ++i) f[i] = (f32x4){0.f, 0.f, 0.f, 0.f};
                    constexpr int NKC = MODE == 1 ? 4 : 11;
#pragma unroll 4
                    for (int kc = 0; kc < NKC; ++kc) {
                        const float* rk = ra + (size_t)kc * 262144;
                        const f32x4 t0 = *(const f32x4*)rk, t1 = *(const f32x4*)(rk + 4), t2 = *(const f32x4*)(rk + 512), t3 = *(const f32x4*)(rk + 516);
                        f[0] += t0; f[1] += t1; f[2] += t2; f[3] += t3;
                    }
                } else {
#pragma unroll
                    for (int hh = 0; hh < 2; ++hh) {
                        const u32x4 v = rw[q][hh];
                        f[2 * hh] = (f32x4){__uint_as_float(v.x << 16), __uint_as_float(v.x & 0xffff0000u), __uint_as_float(v.y << 16), __uint_as_float(v.y & 0xffff0000u)};
                        f[2 * hh + 1] = (f32x4){__uint_as_float(v.z << 16), __uint_as_float(v.z & 0xffff0000u), __uint_as_float(v.w << 16), __uint_as_float(v.w & 0xffff0000u)};
                    }
                }
                float ss = 0.f;
#pragma unroll
                for (int i = 0; i < 4; ++i) ss += f[i][0] * f[i][0] + f[i][1] * f[i][1] + f[i][2] * f[i][2] + f[i][3] * f[i][3];
                ss = wave_sum(ss);
                const float rs = rsqrtf(ss * (1.f / 1024.f) + 1e-6f);
#pragma unroll
                for (int i = 0; i < 4; ++i) x[q][i] += f[i] * rs * gn[i];
            }
            if (MODE == 3) {
                float* yo = p.out + O_Y + (size_t)r * 1024;
#pragma unroll
                for (int hh = 0; hh < 2; ++hh) { __builtin_nontemporal_store(x[q][2 * hh], (f32x4*)(yo + hh * 512 + lane * 8)); __builtin_nontemporal_store(x[q][2 * hh + 1], (f32x4*)(yo + hh * 512 + lane * 8 + 4)); }
            } else {
                float ss = 0.f;
#pragma unroll
                for (int i = 0; i < 4; ++i) ss += x[q][i][0] * x[q][i][0] + x[q][i][1] * x[q][i][1] + x[q][i][2] * x[q][i][2] + x[q][i][3] * x[q][i][3];
                ss = wave_sum(ss);
                const float rs = rsqrtf(ss * (1.f / 1024.f) + 1e-6f);
                if (lane == 0) rstd[r] = rs;
#pragma unroll
                for (int hh = 0; hh < 2; ++hh) {
                    const f32x4 n0 = x[q][2 * hh] * rs, n1 = x[q][2 * hh + 1] * rs;
                    u32x4 w; w.x = pk_bf16(n0[0], n0[1]); w.y = pk_bf16(n0[2], n0[3]); w.z = pk_bf16(n1[0], n1[1]); w.w = pk_bf16(n1[2], n1[3]);
                    *(u32x4*)(xa + (size_t)r * 1024 + hh * 512 + lane * 8) = w;
                }
                if (MODE == 0 || MODE == 2) {
                    float d[8];
#pragma unroll
                    for (int j = 0; j < 8; ++j) {
                        float a = 0.f;
#pragma unroll
                        for (int i = 0; i < 4; ++i) { const f32x4 w = *(const f32x4*)(wl + j * 1024 + (i >> 1) * 512 + lane * 8 + (i & 1) * 4); a += x[q][i][0] * w[0] + x[q][i][1] * w[1] + x[q][i][2] * w[2] + x[q][i][3] * w[3]; }
                        d[j] = wave_sum(a) * rs;
                    }
                    if (lane < 4) {
                        const float braw = lane == 0 ? d[0] : lane == 1 ? d[1] : lane == 2 ? d[2] : d[3];
                        const float araw = lane == 0 ? d[4] : lane == 1 ? d[5] : lane == 2 ? d[6] : d[7];
                        const float beta = 1.f / (1.f + __expf(-braw));
                        const float xv = araw + p.dt_bias[lnext * 4 + lane];
                        const float sp = xv > 20.f ? xv : log1pf(__expf(xv));
                        const float g = -__expf(p.a_log[lnext * 4 + lane]) * sp;
                        ((float*)(ws_fresh(p.ws) + OFF_BETA))[r * 4 + lane] = beta;
                        ((float*)(ws_fresh(p.ws) + OFF_GLOG))[r * 4 + lane] = g;
                    }
                }
            }
        }
    }
}

constexpr int KNS = 136;
constexpr int TBS = 72;
constexpr int C_QN = 0;
constexpr int C_KN = C_QN + 17408;
constexpr int C_VBT = C_KN + 17408;
constexpr int C_KBT = C_VBT + 18432;
constexpr int C_SM = C_KBT + 18432;
constexpr int C_AM = C_SM + 2048;
constexpr int C_TF = C_AM + 16384;
constexpr int C_TB = C_TF + 16384;
constexpr int C_QKL = C_TB + 9216;
constexpr int C_WL = C_QKL + 9216;
static_assert(C_WL + 17408 <= LDS_BYTES - 16, "lds");
#define LBAR() do { asm volatile("s_waitcnt lgkmcnt(0)" ::: "memory"); __builtin_amdgcn_s_barrier(); asm volatile("" ::: "memory"); } while (0)
DI f32x4 bflo4(const u32x4& v) { return (f32x4){__uint_as_float(v.x << 16), __uint_as_float(v.x & 0xffff0000u), __uint_as_float(v.y << 16), __uint_as_float(v.y & 0xffff0000u)}; }
DI f32x4 bfhi4(const u32x4& v) { return (f32x4){__uint_as_float(v.z << 16), __uint_as_float(v.z & 0xffff0000u), __uint_as_float(v.w << 16), __uint_as_float(v.w & 0xffff0000u)}; }
DI float row16_sum(float v) {
    v += __builtin_bit_cast(float, __builtin_amdgcn_update_dpp(0, __builtin_bit_cast(int, v), 0xB1, 0xf, 0xf, true));
    v += __builtin_bit_cast(float, __builtin_amdgcn_update_dpp(0, __builtin_bit_cast(int, v), 0x4E, 0xf, 0xf, true));
    v += __builtin_bit_cast(float, __builtin_amdgcn_update_dpp(0, __builtin_bit_cast(int, v), 0x141, 0xf, 0xf, true));
    v += __builtin_bit_cast(float, __builtin_amdgcn_update_dpp(0, __builtin_bit_cast(int, v), 0x140, 0xf, 0xf, true));
    return v;
}
DI float silu_fast(float x) { return x * __builtin_amdgcn_rcpf(1.f + __expf(-x)); }

DI void write_frags_rowmajor(const bf16_t* X, int ldx, int KS, int nfr, const float* rowscale, __amdgpu_buffer_rsrc_t rs, unsigned dofs, int t0, int nthr) {
    for (int it = t0; it < nfr * 64; it += nthr) {
        const int f = it >> 6, l = it & 63, mt = f / KS, ks = f % KS, m = mt * 16 + (l & 15), g = l >> 4;
        const bf16_t* rp = X + m * ldx + ks * 32 + 4 * g;
        const u32x2 lo = *(const u32x2*)rp, hi = *(const u32x2*)(rp + 16);
        u32x4 o;
        if (rowscale) {
            const float s = rowscale[m];
            o.x = pk_bf16(__uint_as_float(lo.x << 16) * s, __uint_as_float(lo.x & 0xffff0000u) * s);
            o.y = pk_bf16(__uint_as_float(lo.y << 16) * s, __uint_as_float(lo.y & 0xffff0000u) * s);
            o.z = pk_bf16(__uint_as_float(hi.x << 16) * s, __uint_as_float(hi.x & 0xffff0000u) * s);
            o.w = pk_bf16(__uint_as_float(hi.y << 16) * s, __uint_as_float(hi.y & 0xffff0000u) * s);
        } else { o.x = lo.x; o.y = lo.y; o.z = hi.x; o.w = hi.y; }
        __builtin_amdgcn_raw_buffer_store_b128(o, rs, dofs + (unsigned)it * 16u, 0, 16);
    }
}

DI void phase_chunk(const Params& p, int layer, unsigned char* smem, int first_block, int nblk) {
    const int tid = tid_fresh(), wid = tid >> 6, lane = tid & 63, bid = bid_fresh();
    bf16_t* QN = (bf16_t*)(smem + C_QN);
    bf16_t* KN = (bf16_t*)(smem + C_KN);
    bf16_t* VBT = (bf16_t*)(smem + C_VBT);
    bf16_t* KBT = (bf16_t*)(smem + C_KBT);
    bf16_t* QKL = (bf16_t*)(smem + C_QKL);
    bf16_t* TB = (bf16_t*)(smem + C_TB);
    float* SM = (float*)(smem + C_SM);
    float *GC = SM, *BETA = SM + 64, *EG = SM + 128, *EGL = SM + 192, *QS = SM + 256, *KS_ = SM + 320, *BE = SM + 384;
    float* AM = (float*)(smem + C_AM);
    float* TF = (float*)(smem + C_TF);
    bf16_t* WL = (bf16_t*)(smem + C_WL);
    const bf16_t* pqkv = (const bf16_t*)(ws_fresh(p.ws) + OFF_PQKV);
    const bf16_t* psc = (const bf16_t*)(ws_fresh(p.ws) + OFF_PSC);
    bf16_t* mixin = (bf16_t*)(p.out + O_Y);
    const float* betaA = (const float*)(ws_fresh(p.ws) + OFF_BETA);
    const float* glogA = (const float*)(ws_fresh(p.ws) + OFF_GLOG);

    unsigned* readyc = (unsigned*)(ws_fresh(p.ws) + OFF_FLAG) + layer * 528;
    int pending_c = -1;
    u32x4 raw[11];
    float gvp = 0.f, bvp = 0.f;
    auto issue_loads = [&](const int o2) __attribute__((always_inline)) {
        const int u2 = o2 < 2048 ? ((((o2 >> 2) & 1) * 256 + (o2 >> 3)) * 4 + (o2 & 3)) : o2;
        const int c2 = u2 >> 2, h2 = u2 & 3;
        int row02, nvalid2; bool first2;
        if (c2 < 512) { const int b2 = c2 >> 8, n2 = c2 & 255; row02 = b2 * 16384 + n2 * 64; nvalid2 = 64; first2 = n2 == 0; }
        else { row02 = TP + (c2 - 512) * 16; nvalid2 = 16; first2 = true; }
        const int tid2 = tid_fresh();
        if (tid2 < 384) {
            const int rg2 = tid2 / 48, cg2 = tid2 % 48, col02 = (cg2 >> 4) * 512 + h2 * 128 + (cg2 & 15) * 8;
#pragma unroll
            for (int i = 0; i < 11; ++i) {
                int rr = rg2 * 8 - 3 + i;
                if (rr >= nvalid2) rr = 0;
                if (rr < 0 && first2) rr = 0;
                raw[i] = *(const u32x4*)(pqkv + (size_t)(row02 + rr) * 1536 + col02);
            }
        }
        if ((tid2 >> 6) == 7) {
            const int l2 = tid2 & 63, rl = l2 < nvalid2 ? l2 : 0;
            gvp = glogA[(size_t)(row02 + rl) * 4 + h2]; bvp = betaA[(size_t)(row02 + rl) * 4 + h2];
        }
    };
    if (bid - first_block < NCHH) issue_loads(bid - first_block);
    for (int o = bid - first_block; o < NCHH; o += nblk) {
        const int u = o < 2048 ? ((((o >> 2) & 1) * 256 + (o >> 3)) * 4 + (o & 3)) : o;
        const int c = u >> 2, h = u & 3;
        int row0, nvalid, sb = 0; bool first, lastc, prompt = c < 512;
        if (prompt) { const int b = c >> 8, n = c & 255; row0 = b * 16384 + n * 64; nvalid = 64; first = n == 0; lastc = n == 255; sb = b; }
        else { sb = c - 512; row0 = TP + sb * 16; nvalid = 16; first = true; lastc = true; }
        unsigned char* frb = ws_fresh(p.ws) + OFF_FR + (size_t)u * FR_STRIDE;
        const __amdgpu_buffer_rsrc_t frr = __builtin_amdgcn_make_buffer_rsrc(frb, 0, (int)FR_STRIDE, 0x00020000);

        const int rg = tid / 48, cg = tid % 48, which = cg >> 4, c0 = (cg & 15) * 8, col0 = which * 512 + h * 128 + c0, r0 = rg * 8;
        const bool use_cache = (tid < 384) && rg == 0 && first && !prompt;
        if (wid == 7) {
            const int r = lane;
            const float gv = r < nvalid ? gvp : 0.f, bv = r < nvalid ? bvp : 0.f;
            float cs = gv;
#pragma unroll
            for (int o = 1; o < 64; o <<= 1) { const float t = __shfl_up(cs, o); if (lane >= o) cs += t; }
            const float gl = __shfl(cs, 63);
            const float egv = __expf(cs); GC[r] = cs; BETA[r] = bv; EG[r] = egv; BE[r] = bv * egv; EGL[r] = __expf(gl - cs);
            const float alx = __expf(gl);
            if (r == 0) __hip_atomic_store((float*)(ws_fresh(p.ws) + OFF_AL) + u, alx, __ATOMIC_RELAXED, __HIP_MEMORY_SCOPE_AGENT);
            { const unsigned ab = __float_as_uint(alx); __builtin_amdgcn_raw_buffer_store_b128((u32x4){ab, ab, ab, ab}, frr, (unsigned)(FR_META + lane * 16), 0, 16); }
        }
        asm volatile("s_waitcnt vmcnt(0)" ::: "memory");
        __syncthreads();
        if (pending_c >= 0 && tid == 0) __hip_atomic_fetch_add(readyc + pending_c, 1u, __ATOMIC_RELAXED, __HIP_MEMORY_SCOPE_AGENT);
        if (tid < 384) {
            const float* cw = p.conv_w + layer * 4 * 1536 + col0;
            f32x4 wv[4][2];
#pragma unroll
            for (int i = 0; i < 4; ++i) { wv[i][0] = *(const f32x4*)(cw + i * 1536); wv[i][1] = *(const f32x4*)(cw + i * 1536 + 4); }
            f32x4 xin[11][2];
#pragma unroll
            for (int i = 0; i < 11; ++i) {
                xin[i][0] = bflo4(raw[i]); xin[i][1] = bfhi4(raw[i]);
                if (i < 3 && rg == 0 && first) {
                    if (use_cache) {
                        const float* cp = p.cache_conv + ((size_t)(layer * 16 + sb) * 3 + i) * 1536 + col0;
                        xin[i][0] = *(const f32x4*)cp; xin[i][1] = *(const f32x4*)(cp + 4);
                    } else { xin[i][0] = (f32x4){0.f, 0.f, 0.f, 0.f}; xin[i][1] = xin[i][0]; }
                }
            }
            if (lastc && r0 + 8 == ((nvalid + 7) & ~7) ) {
                float* co = prompt ? p.out + O_CONVP + ((size_t)(layer * 2 + sb) * 3) * 1536 + col0 : p.out + O_CONVS + ((size_t)(layer * 16 + sb) * 3) * 1536 + col0;
                const int jl = nvalid - 1 - r0;
#pragma unroll
                for (int i = 0; i < 3; ++i) { *(f32x4*)(co + i * 1536) = xin[jl + 1 + i][0]; *(f32x4*)(co + i * 1536 + 4) = xin[jl + 1 + i][1]; }
            }
#pragma unroll
            for (int hf = 0; hf < 2; ++hf) {
                float yv[4][8];
#pragma unroll
                for (int jj = 0; jj < 4; ++jj) {
                    const int j = hf * 4 + jj;
                    const bool valid = r0 + j < nvalid;
                    const f32x4 a0 = wv[0][0] * xin[j][0] + wv[1][0] * xin[j + 1][0] + wv[2][0] * xin[j + 2][0] + wv[3][0] * xin[j + 3][0];
                    const f32x4 a1 = wv[0][1] * xin[j][1] + wv[1][1] * xin[j + 1][1] + wv[2][1] * xin[j + 2][1] + wv[3][1] * xin[j + 3][1];
#pragma unroll
                    for (int e = 0; e < 4; ++e) { yv[jj][e] = valid ? silu_fast(a0[e]) : 0.f; yv[jj][4 + e] = valid ? silu_fast(a1[e]) : 0.f; }
                }
                if (which < 2) {
                    bf16_t* dstn = (which ? KN : QN);
#pragma unroll
                    for (int jj = 0; jj < 4; ++jj) {
                        float ss = 0.f;
#pragma unroll
                        for (int e = 0; e < 8; ++e) ss += yv[jj][e] * yv[jj][e];
                        ss = row16_sum(ss);
                        const float sc = rsqrtf(ss + 1e-6f) * (which ? 1.f : 0.08838834764831845f);
#pragma unroll
                        for (int e = 0; e < 8; ++e) yv[jj][e] *= sc;
                        u32x4 w; w.x = pk_bf16(yv[jj][0], yv[jj][1]); w.y = pk_bf16(yv[jj][2], yv[jj][3]); w.z = pk_bf16(yv[jj][4], yv[jj][5]); w.w = pk_bf16(yv[jj][6], yv[jj][7]);
                        *(u32x4*)(dstn + (r0 + hf * 4 + jj) * KNS + c0) = w;
                    }
                }
                if (which >= 1) {
                    bf16_t* dstt = (which == 1 ? KBT : VBT);
                    const float* scl = (which == 1 ? BE : BETA);
                    float sc4[4];
#pragma unroll
                    for (int jj = 0; jj < 4; ++jj) sc4[jj] = scl[r0 + hf * 4 + jj];
#pragma unroll
                    for (int e = 0; e < 8; ++e) {
                        u32x2 w; w.x = pk_bf16(yv[0][e] * sc4[0], yv[1][e] * sc4[1]); w.y = pk_bf16(yv[2][e] * sc4[2], yv[3][e] * sc4[3]);
                        *(u32x2*)(dstt + (c0 + e) * TBS + r0 + hf * 4) = w;
                    }
                }
            }
        } else {
#pragma unroll 1
            for (int kb = 0; kb < 2; ++kb) {
                u32x4 scv[2][4], shv[2][4], sbv[2][2];
#pragma unroll
                for (int k2 = 0; k2 < 2; ++k2) {
                    const int it = (tid - 384) + 128 * (kb * 2 + k2), sr0 = (it >> 4) * 2, ch0 = h * 128 + (it & 15) * 8;
#pragma unroll
                    for (int i = 0; i < 4; ++i) {
                        int rr = sr0 - 2 + i;
                        if (rr >= nvalid) rr = 0;
                        if (rr < 0 && first) rr = 0;
                        const bf16_t* rp = psc + (size_t)(row0 + rr) * 1536 + ch0;
                        scv[k2][i] = *(const u32x4*)(rp + 512); shv[k2][i] = *(const u32x4*)(rp + 1024);
                        if (i >= 2) sbv[k2][i - 2] = *(const u32x4*)rp;
                    }
                }
#pragma unroll
                for (int k2 = 0; k2 < 2; ++k2) {
                    const int it = (tid - 384) + 128 * (kb * 2 + k2), sr0 = (it >> 4) * 2, ch0 = h * 128 + (it & 15) * 8;
                    if (sr0 < nvalid) {
                        const float* cw = p.conv_sc_w + layer * 3 * 512 + ch0;
                        f32x4 wv[3][2];
#pragma unroll
                        for (int i = 0; i < 3; ++i) { wv[i][0] = *(const f32x4*)(cw + i * 512); wv[i][1] = *(const f32x4*)(cw + i * 512 + 4); }
                        f32x4 pr[4][2];
#pragma unroll
                        for (int i = 0; i < 4; ++i) {
                            const int rr = sr0 - 2 + i;
                            if (rr < 0 && first) {
                                if (prompt) { pr[i][0] = (f32x4){0.f, 0.f, 0.f, 0.f}; pr[i][1] = pr[i][0]; }
                                else { const float* cp = p.cache_sc + ((size_t)(layer * 16 + sb) * 2 + (rr + 2)) * 512 + ch0; pr[i][0] = *(const f32x4*)cp; pr[i][1] = *(const f32x4*)(cp + 4); }
                            } else { pr[i][0] = bflo4(scv[k2][i]) * bflo4(shv[k2][i]); pr[i][1] = bfhi4(scv[k2][i]) * bfhi4(shv[k2][i]); }
                        }
#pragma unroll
                        for (int j = 0; j < 2; ++j) {
                            const u32x4 bvv = sbv[k2][j];
                            const f32x4 y0 = bflo4(bvv) * (wv[0][0] * pr[j][0] + wv[1][0] * pr[j + 1][0] + wv[2][0] * pr[j + 2][0]);
                            const f32x4 y1 = bfhi4(bvv) * (wv[0][1] * pr[j][1] + wv[1][1] * pr[j + 1][1] + wv[2][1] * pr[j + 2][1]);
                            u32x4 w; w.x = pk_bf16(y0[0], y0[1]); w.y = pk_bf16(y0[2], y0[3]); w.z = pk_bf16(y1[0], y1[1]); w.w = pk_bf16(y1[2], y1[3]);
                            *(u32x4*)(mixin + (size_t)(row0 + sr0 + j) * 1024 + 512 + ch0) = w;
                        }
                        if (lastc && sr0 == nvalid - 2) {
                            float* co = prompt ? p.out + O_SCP + ((size_t)(layer * 2 + sb) * 2) * 512 + ch0 : p.out + O_SCS + ((size_t)(layer * 16 + sb) * 2) * 512 + ch0;
                            *(f32x4*)co = pr[2][0]; *(f32x4*)(co + 4) = pr[2][1]; *(f32x4*)(co + 512) = pr[3][0]; *(f32x4*)(co + 516) = pr[3][1];
                        }
                    }
                }
            }
        }
        __syncthreads();
        const int tidb = tid_fresh(), widb = tidb >> 6, laneb = tidb & 63;
        for (int job = widb; job < 32; job += 8) {
            const int isqk = job >> 4, mi = (job >> 2) & 3, nj = job & 3;
            const int g = laneb >> 4, n = laneb & 15;
            if (mi < nj) {
#pragma unroll
                for (int e = 0; e < 4; ++e) { bf16_t* dst = (isqk ? QKL : TB) + (mi * 16 + 4 * g + e) * TBS + nj * 16 + n; *dst = 0; }
                continue;
            }
            const bf16_t* Arow = (isqk ? QN : KN) + (mi * 16 + n) * KNS + g * 8;
            const bf16_t* Brow = KN + (nj * 16 + n) * KNS + g * 8;
            f32x4 acc = {0.f, 0.f, 0.f, 0.f};
#pragma unroll
            for (int ks = 0; ks < 4; ++ks) {
                const bf16x8 a = *(const bf16x8*)(Arow + ks * 32), b = *(const bf16x8*)(Brow + ks * 32);
                acc = MFMA16(a, b, acc);
            }
            const int j = nj * 16 + n; const float gj = GC[j];
            if (isqk) {
#pragma unroll
                for (int e = 0; e < 4; ++e) {
                    const int i = mi * 16 + 4 * g + e;
                    const float v = (i >= j) ? acc[e] * __expf(GC[i] - gj) : 0.f; QKL[i * TBS + j] = f2bf(v);
                }
            } else {
                f32x4 v;
#pragma unroll
                for (int e = 0; e < 4; ++e) { const int i = mi * 16 + 4 * g + e; v[e] = (i > j) ? acc[e] * BETA[i] * __expf(GC[i] - gj) : 0.f; }
                *(f32x4*)(AM + j * 64 + mi * 16 + 4 * g) = v;
            }
        }
        __syncthreads();
        if (widb == 0) {
            const int b = laneb >> 4, cx = laneb & 15;
            const float* Ab = AM + (16 * b) * 64 + 16 * b;
            float x[16];
#pragma unroll
            for (int i = 0; i < 16; ++i) {
                float a = (i == cx) ? 1.f : 0.f;
#pragma unroll
                for (int j = 0; j < i; ++j) a -= Ab[j * 64 + i] * x[j];
                x[i] = a;
            }
#pragma unroll
            for (int i = 0; i < 16; ++i) { TF[(16 * b + i) * 64 + 16 * b + cx] = x[i]; TB[(16 * b + i) * TBS + 16 * b + cx] = f2bf(x[i]); }
        } else if (widb >= 4) {
            const int t0 = tidb - 256;
            write_frags_rowmajor(QN, KNS, 4, 16, EG, frr, (unsigned)FR_QG, t0, 256);
            write_frags_rowmajor(QKL, TBS, 2, 8, nullptr, frr, (unsigned)FR_QK, t0, 256);
            for (int it = t0; it < 16 * 64; it += 256) {
                const int f = it >> 6, l = it & 63, mt = f >> 1, ks = f & 1, m = mt * 16 + (l & 15), g = l >> 4;
                float v[8];
#pragma unroll
                for (int e = 0; e < 8; ++e) { const int j = ks * 32 + 16 * (e >> 2) + 4 * g + (e & 3); v[e] = bf2f(KN[j * KNS + m]) * EGL[j]; }
                u32x4 o; o.x = pk_bf16(v[0], v[1]); o.y = pk_bf16(v[2], v[3]); o.z = pk_bf16(v[4], v[5]); o.w = pk_bf16(v[6], v[7]);
                __builtin_amdgcn_raw_buffer_store_b128(o, frr, (unsigned)(FR_KT + it * 16), 0, 16);
            }
        }
        __syncthreads();
        if (o + nblk < NCHH) issue_loads(o + nblk);
#pragma unroll
        for (int d = 1; d < 4; ++d) {
            if (widb < 4 - d) {
                const int b = widb, bi = b + d, g = laneb >> 4, n = laneb & 15;
                f32x4 acc = {0.f, 0.f, 0.f, 0.f};
                for (int k = b; k < bi; ++k) {
#pragma unroll
                    for (int ks = 0; ks < 4; ++ks) {
                        const float av = AM[(16 * k + 4 * ks + g) * 64 + 16 * bi + n];
                        const float bv = TF[(16 * k + 4 * ks + g) * 64 + 16 * b + n];
                        acc = __builtin_amdgcn_mfma_f32_16x16x4f32(av, bv, acc, 0, 0, 0);
                    }
                }
                f32x4 res = {0.f, 0.f, 0.f, 0.f};
#pragma unroll
                for (int e = 0; e < 4; ++e) {
                    const float dv = TF[(16 * bi + n) * 64 + 16 * bi + 4 * g + e];
                    res = __builtin_amdgcn_mfma_f32_16x16x4f32(dv, acc[e], res, 0, 0, 0);
                }
#pragma unroll
                for (int e = 0; e < 4; ++e) { const int i = 16 * bi + 4 * g + e; TF[i * 64 + 16 * b + n] = -res[e]; TB[i * TBS + 16 * b + n] = f2bf(-res[e]); }
            }
            LBAR();
        }
        {
            const int g = laneb >> 4, n = laneb & 15;
            bf16x8 ta[4][2];
#pragma unroll
            for (int mt = 0; mt < 4; ++mt)
#pragma unroll
                for (int ks = 0; ks < 2; ++ks) ta[mt][ks] = *(const bf16x8*)(TB + (mt * 16 + n) * TBS + ks * 32 + g * 8);
            f32x4 uo[4], wo[4];
#pragma unroll
            for (int mt = 0; mt < 4; ++mt) { uo[mt] = (f32x4){0.f, 0.f, 0.f, 0.f}; wo[mt] = (f32x4){0.f, 0.f, 0.f, 0.f}; }
#pragma unroll
            for (int ks = 0; ks < 2; ++ks) {
                const bf16x8 bu = *(const bf16x8*)(VBT + (widb * 16 + n) * TBS + ks * 32 + g * 8);
                const bf16x8 bw = *(const bf16x8*)(KBT + (widb * 16 + n) * TBS + ks * 32 + g * 8);
#pragma unroll
                for (int mt = 0; mt < 4; ++mt) { uo[mt] = MFMA16(ta[mt][ks], bu, uo[mt]); wo[mt] = MFMA16(ta[mt][ks], bw, wo[mt]); }
            }
            u32x4 a, b2;
            a.x = pk_bf16(uo[0][0], uo[0][1]); a.y = pk_bf16(uo[0][2], uo[0][3]); a.z = pk_bf16(uo[1][0], uo[1][1]); a.w = pk_bf16(uo[1][2], uo[1][3]);
            b2.x = pk_bf16(uo[2][0], uo[2][1]); b2.y = pk_bf16(uo[2][2], uo[2][3]); b2.z = pk_bf16(uo[3][0], uo[3][1]); b2.w = pk_bf16(uo[3][2], uo[3][3]);
            const unsigned uofs = (unsigned)(FR_U + (widb * 64 + laneb) * 32);
            __builtin_amdgcn_raw_buffer_store_b128(a, frr, uofs, 0, 16); __builtin_amdgcn_raw_buffer_store_b128(b2, frr, uofs + 16u, 0, 16);
#pragma unroll
            for (int mt = 0; mt < 4; ++mt)
#pragma unroll
                for (int e = 0; e < 4; ++e) WL[(mt * 16 + 4 * g + e) * KNS + widb * 16 + n] = f2bf(wo[mt][e]);
        }
        LBAR();
        write_frags_rowmajor(WL, KNS, 4, 16, nullptr, frr, (unsigned)FR_W, tidb, 512);
        pending_c = c;
    }
    asm volatile("s_waitcnt vmcnt(0)" ::: "memory");
    __syncthreads();
    if (pending_c >= 0 && tid == 0) __hip_atomic_fetch_add(readyc + pending_c, 1u, __ATOMIC_RELAXED, __HIP_MEMORY_SCOPE_AGENT);
}

DI void scan_task(const Params& p, int layer, int u0, int nsteps, const float* s0, float* sout, int s, int lane) {
    const int g = lane >> 4, n = lane & 15;
    f32x4 S[8];
#pragma unroll
    for (int mt = 0; mt < 8; ++mt)
#pragma unroll
        for (int e = 0; e < 4; ++e) S[mt][e] = s0 ? s0[(size_t)(mt * 16 + 4 * g + e) * 128 + s * 16 + n] : 0.f;
    const float* alA = (const float*)(ws_fresh(p.ws) + OFF_AL);
    for (int st = 0; st < nsteps; ++st) {
        const int u = u0 + st * 4;
        const unsigned char* frb = ws_fresh(p.ws) + OFF_FR + (size_t)u * FR_STRIDE;
        const u32x4* wf = (const u32x4*)(frb + FR_W) + lane;
        const u32x4* kf = (const u32x4*)(frb + FR_KT) + lane;
        const u32x4* uf = (const u32x4*)(frb + FR_U + (size_t)(s * 64 + lane) * 32);
        bf16x8 Sb[4];
#pragma unroll
        for (int ks = 0; ks < 4; ++ks) Sb[ks] = pack8(S[2 * ks], S[2 * ks + 1]);
        u32x4* sfr = (u32x4*)(sv_home(p, u) + (size_t)s * 4096) + lane;
#pragma unroll
        for (int ks = 0; ks < 4; ++ks) sfr[ks * 64] = __builtin_bit_cast(u32x4, Sb[ks]);
        const u32x4 u0v = uf[0], u1v = uf[1];
        f32x4 vn[4];
#pragma unroll
        for (int mt = 0; mt < 4; ++mt) {
            f32x4 acc = {0.f, 0.f, 0.f, 0.f};
#pragma unroll
            for (int ks = 0; ks < 4; ++ks) acc = MFMA16(__builtin_bit_cast(bf16x8, wf[(mt * 4 + ks) * 64]), Sb[ks], acc);
            const unsigned lo = mt == 0 ? u0v.x : mt == 1 ? u0v.z : mt == 2 ? u1v.x : u1v.z;
            const unsigned hi = mt == 0 ? u0v.y : mt == 1 ? u0v.w : mt == 2 ? u1v.y : u1v.w;
            vn[mt][0] = __uint_as_float(lo << 16) - acc[0]; vn[mt][1] = __uint_as_float(lo & 0xffff0000u) - acc[1];
            vn[mt][2] = __uint_as_float(hi << 16) - acc[2]; vn[mt][3] = __uint_as_float(hi & 0xffff0000u) - acc[3];
        }
        bf16x8 Vb[2];
        Vb[0] = pack8(vn[0], vn[1]); Vb[1] = pack8(vn[2], vn[3]);
        u32x4* vfr = (u32x4*)(sv_home(p, u) + 32768 + (size_t)s * 2048) + lane;
        vfr[0] = __builtin_bit_cast(u32x4, Vb[0]); vfr[64] = __builtin_bit_cast(u32x4, Vb[1]);
        const float al = alA[u];
#pragma unroll
        for (int mt = 0; mt < 8; ++mt) {
            S[mt] *= al;
#pragma unroll
            for (int ks = 0; ks < 2; ++ks) S[mt] = MFMA16(__builtin_bit_cast(bf16x8, kf[(mt * 2 + ks) * 64]), Vb[ks], S[mt]);
        }
    }
#pragma unroll
    for (int mt = 0; mt < 8; ++mt)
#pragma unroll
        for (int e = 0; e < 4; ++e) sout[(size_t)(mt * 16 + 4 * g + e) * 128 + s * 16 + n] = S[mt][e];
}
constexpr int SC_SLOT = 35840, SC_D = 3;
DI void scan_prompt(const Params& p, int layer, LAS unsigned char* lds, int tid, int b) {
    const int wid = __builtin_amdgcn_readfirstlane(tid >> 6), lane = tid & 63, g = lane >> 4, n = lane & 15;
    const int xcd = b & 7, s = b >> 3, bb = xcd >> 2, h = xcd & 3;
    const int u0 = (bb * 256) * 4 + h;
    const unsigned char* fr0 = ws_fresh(p.ws) + OFF_FR + (size_t)u0 * FR_STRIDE;
    const size_t stepB = 4 * FR_STRIDE;
    unsigned* readyc = (unsigned*)(ws_fresh(p.ws) + OFF_FLAG) + layer * 528 + bb * 256;
#define SC_ISSUE(st, slot) do { const unsigned char* _f = fr0 + (size_t)(st) * stepB; \
        _Pragma("unroll") for (int _i = 0; _i < 6; ++_i) { const int _q = (wid - 2) * 6 + _i; if (_q < 35) { \
            const unsigned char* _src = _q < 32 ? _f + _q * 1024 + lane * 16 : _q < 34 ? _f + FR_U + (size_t)(s * 64 + lane) * 32 + (_q - 32) * 16 : _f + FR_META + lane * 16; \
            __builtin_amdgcn_global_load_lds((const unsigned*)_src, (LAS unsigned*)(lds + (slot) * SC_SLOT + _q * 1024), 16, 0, 0); } } } while (0)
    f32x4 S[8];
#pragma unroll
    for (int mt = 0; mt < 8; ++mt) S[mt] = (f32x4){0.f, 0.f, 0.f, 0.f};
    if (wid == 1) { wait_counts8(readyc, 0, 255, lane, 4u); wait_counts8(readyc, 3, 255, lane, 4u); }
    asm volatile("" ::: "memory");
    __builtin_amdgcn_s_barrier();
    asm volatile("" ::: "memory");
    if (wid >= 2) {
#pragma unroll
        for (int st = 0; st < SC_D; ++st) SC_ISSUE(st, st);
    }
    if (wid == 7) asm volatile("s_waitcnt vmcnt(10)" ::: "memory");
    else if (wid >= 2) asm volatile("s_waitcnt vmcnt(12)" ::: "memory");
    asm volatile("" ::: "memory");
    __builtin_amdgcn_s_barrier();
    asm volatile("" ::: "memory");
    if (wid >= 2) SC_ISSUE(SC_D, SC_D & 3);
    bf16x8 wfr[16]; u32x4 u0v = {0u, 0u, 0u, 0u}, u1v = {0u, 0u, 0u, 0u}; float al = 0.f;
    if (wid == 0) {
        LAS const unsigned char* sb = lds + lane * 16;
        u0v = *(LAS const u32x4*)(sb + 32768); u1v = *(LAS const u32x4*)(sb + 33792); al = *(LAS const float*)(lds + 34816);
#pragma unroll
        for (int f = 0; f < 16; ++f) wfr[f] = *(LAS const bf16x8*)(sb + f * 1024);
    }
    for (int st = 0; st < 256; ++st) {
        const int k = st + 1;
        if (wid != 0) {
            if (wid == 1) { if ((k & 7) == 0 && k + SC_D < 256) wait_counts8(readyc, k + SC_D, 255, lane, 4u); }
            else if (wid == 7) asm volatile("s_waitcnt vmcnt(10)" ::: "memory");
            else asm volatile("s_waitcnt vmcnt(12)" ::: "memory");
            asm volatile("" ::: "memory");
            __builtin_amdgcn_s_barrier();
            asm volatile("" ::: "memory");
            if (wid >= 2) { const int nx = k + SC_D < 256 ? k + SC_D : 255; SC_ISSUE(nx, (k + SC_D) & 3); }
        } else {
            const int u = u0 + st * 4;
            LAS const unsigned char* sb = lds + (st & 3) * SC_SLOT + lane * 16;
            unsigned char* svh = sv_home(p, u);
            bf16x8 Sb[4];
#pragma unroll
            for (int ks = 0; ks < 4; ++ks) Sb[ks] = pack8(S[2 * ks], S[2 * ks + 1]);
            u32x4* sfr = (u32x4*)(svh + (size_t)s * 4096) + lane;
#pragma unroll
            for (int ks = 0; ks < 4; ++ks) __builtin_nontemporal_store(__builtin_bit_cast(u32x4, Sb[ks]), sfr + ks * 64);
            f32x4 vn[4];
#pragma unroll
            for (int mt = 0; mt < 4; ++mt) vn[mt] = (f32x4){0.f, 0.f, 0.f, 0.f};
#pragma unroll
            for (int ks = 0; ks < 4; ++ks)
#pragma unroll
                for (int mt = 0; mt < 4; ++mt) vn[mt] = MFMA16(wfr[mt * 4 + ks], Sb[ks], vn[mt]);
            __builtin_amdgcn_sched_barrier(0);
            bf16x8 kfr[16];
#pragma unroll
            for (int f = 0; f < 16; ++f) kfr[f] = *(LAS const bf16x8*)(sb + 16384 + f * 1024);
#pragma unroll
            for (int mt = 0; mt < 4; ++mt) {
                const unsigned lo = mt == 0 ? u0v.x : mt == 1 ? u0v.z : mt == 2 ? u1v.x : u1v.z;
                const unsigned hi = mt == 0 ? u0v.y : mt == 1 ? u0v.w : mt == 2 ? u1v.y : u1v.w;
                vn[mt][0] = __uint_as_float(lo << 16) - vn[mt][0]; vn[mt][1] = __uint_as_float(lo & 0xffff0000u) - vn[mt][1];
                vn[mt][2] = __uint_as_float(hi << 16) - vn[mt][2]; vn[mt][3] = __uint_as_float(hi & 0xffff0000u) - vn[mt][3];
            }
            bf16x8 Vb[2];
            Vb[0] = pack8(vn[0], vn[1]); Vb[1] = pack8(vn[2], vn[3]);
            u32x4* vfr = (u32x4*)(svh + 32768 + (size_t)s * 2048) + lane;
            __builtin_nontemporal_store(__builtin_bit_cast(u32x4, Vb[0]), vfr); __builtin_nontemporal_store(__builtin_bit_cast(u32x4, Vb[1]), vfr + 64);
            const float alc = al;
            asm volatile("s_waitcnt lgkmcnt(0)" ::: "memory");
            __builtin_amdgcn_sched_barrier(0);
            __builtin_amdgcn_s_barrier();
            asm volatile("" ::: "memory");
            __builtin_amdgcn_sched_barrier(0);
            if (k < 256) {
                LAS const unsigned char* sn = lds + (k & 3) * SC_SLOT + lane * 16;
                u0v = *(LAS const u32x4*)(sn + 32768); u1v = *(LAS const u32x4*)(sn + 33792); al = *(LAS const float*)(lds + (k & 3) * SC_SLOT + 34816);
#pragma unroll
                for (int f = 0; f < 16; ++f) wfr[f] = *(LAS const bf16x8*)(sn + f * 1024);
            }
            __builtin_amdgcn_sched_barrier(0);
#pragma unroll
            for (int mt = 0; mt < 8; ++mt) S[mt] *= alc;
#pragma unroll
            for (int ks = 0; ks < 2; ++ks)
#pragma unroll
                for (int mt = 0; mt < 8; ++mt) S[mt] = MFMA16(kfr[mt * 2 + ks], Vb[ks], S[mt]);
        }
    }
    if (wid >= 2) asm volatile("s_waitcnt vmcnt(0)" ::: "memory");
    else if (wid == 0) {
        float* sout = p.out + O_STP + ((size_t)(layer * 2 + bb) * 4 + h) * 16384;
#pragma unroll
        for (int mt = 0; mt < 8; ++mt)
#pragma unroll
            for (int e = 0; e < 4; ++e) sout[(size_t)(mt * 16 + 4 * g + e) * 128 + s * 16 + n] = S[mt][e];
    }
#undef SC_ISSUE
}
DI void phase_chunk_scan(const Params& p, int layer, unsigned char* smem, LAS unsigned char* lds) {
    const int b = bid_fresh();
    if (b < 64) {
        scan_prompt(p, layer, lds, tid_fresh(), b);
    } else {
        phase_chunk(p, layer, smem, 64, (int)gridDim.x - 64);
        const int tid = tid_fresh(), wid = tid >> 6, lane = tid & 63;
        unsigned* readyc = (unsigned*)(ws_fresh(p.ws) + OFF_FLAG) + layer * 528;
        for (int t = (b - 64) * 8 + wid; t < 512; t += (gridDim.x - 64) * 8) {
            const int sb = t >> 5, h = (t >> 3) & 3, s = t & 7;
            wait_count(readyc + 512 + sb, 4u);
            scan_task(p, layer, (512 + sb) * 4 + h, 1, p.state0 + ((size_t)(layer * 16 + sb) * 4 + h) * 16384,
                      p.out + O_STS + ((size_t)(layer * 16 + sb) * 4 + h) * 16384, s, lane);
        }
    }
}

DI void phase_out(const Params& p, int layer) {
    const int tid = tid_fresh(), wid = tid >> 6, lane = tid & 63, g = lane >> 4, n = lane & 15, bid = bid_fresh();
    const bf16_t* pz = (const bf16_t*)(ws_fresh(p.ws) + OFF_PZ);
    bf16_t* mixin = (bf16_t*)(p.out + O_Y);
    f32x4 gwv[8];
#pragma unroll
    for (int s = 0; s < 8; ++s) gwv[s] = *(const f32x4*)(p.gdn_nw + layer * 128 + s * 16 + 4 * g);
    for (int t = bid * 8 + wid; t < 4096 + 64; t += gridDim.x * 8) {
        int u, mt0; bool two;
        if (t < 4096) { u = t >> 1; mt0 = (t & 1) * 2; two = true; } else { u = 2048 + (t - 4096); mt0 = 0; two = false; }
        const int c = u >> 2, h = u & 3;
        int row0, nvalid;
        if (c < 512) { row0 = (c >> 8) * 16384 + (c & 255) * 64; nvalid = 64; } else { row0 = TP + (c - 512) * 16; nvalid = 16; }
        const unsigned char* frb = ws_fresh(p.ws) + OFF_FR + (size_t)u * FR_STRIDE;
        const u32x4* qgf = (const u32x4*)(frb + FR_QG) + lane;
        const u32x4* qkf = (const u32x4*)(frb + FR_QK) + lane;
        const unsigned char* svh = sv_home(p, u);
        const u32x4* sfr = (const u32x4*)svh + lane;
        const u32x4* vfr = (const u32x4*)(svh + 32768) + lane;
        u32x2 zv[2][8];
#pragma unroll
        for (int q = 0; q < 2; ++q) {
            const int r = (mt0 + q) * 16 + n;
            const size_t grow = (size_t)(row0 + ((r < nvalid && (q == 0 || two)) ? r : 0));
            const bf16_t* zr = pz + grow * 512 + h * 128 + 4 * g;
#pragma unroll
            for (int s = 0; s < 8; ++s) zv[q][s] = *(const u32x2*)(zr + s * 16);
        }
        bf16x8 qg[2][4], qk[2][2];
#pragma unroll
        for (int q = 0; q < 2; ++q) {
            const int mt = two ? mt0 + q : 0;
#pragma unroll
            for (int ks = 0; ks < 4; ++ks) qg[q][ks] = __builtin_bit_cast(bf16x8, qgf[(mt * 4 + ks) * 64]);
#pragma unroll
            for (int ks = 0; ks < 2; ++ks) qk[q][ks] = __builtin_bit_cast(bf16x8, qkf[(mt * 2 + ks) * 64]);
        }
        f32x4 o[2][8];
#pragma unroll
        for (int s = 0; s < 8; ++s) {
            bf16x8 sb[4], vb[2];
#pragma unroll
            for (int ks = 0; ks < 4; ++ks) sb[ks] = __builtin_bit_cast(bf16x8, sfr[(s * 4 + ks) * 64]);
#pragma unroll
            for (int ks = 0; ks < 2; ++ks) vb[ks] = __builtin_bit_cast(bf16x8, vfr[(s * 2 + ks) * 64]);
#pragma unroll
            for (int q = 0; q < 2; ++q) {
                f32x4 acc = {0.f, 0.f, 0.f, 0.f};
#pragma unroll
                for (int ks = 0; ks < 4; ++ks) acc = MFMA16(sb[ks], qg[q][ks], acc);
#pragma unroll
                for (int ks = 0; ks < 2; ++ks) acc = MFMA16(vb[ks], qk[q][ks], acc);
                o[q][s] = acc;
            }
        }
#pragma unroll
        for (int q = 0; q < 2; ++q) {
            float v = 0.f;
#pragma unroll
            for (int s = 0; s < 8; ++s) v += o[q][s][0] * o[q][s][0] + o[q][s][1] * o[q][s][1] + o[q][s][2] * o[q][s][2] + o[q][s][3] * o[q][s][3];
            v += __shfl_xor(v, 16); v += __shfl_xor(v, 32);
            const float rs = rsqrtf(v * (1.f / 128.f) + 1e-6f);
            const int r = (mt0 + q) * 16 + n;
            if (r < nvalid && (q == 0 || two)) {
                bf16_t* mr = mixin + (size_t)(row0 + r) * 1024 + h * 128 + 4 * g;
#pragma unroll
                for (int s = 0; s < 8; ++s) {
                    const float z0 = __uint_as_float(zv[q][s].x << 16), z1 = __uint_as_float(zv[q][s].x & 0xffff0000u), z2 = __uint_as_float(zv[q][s].y << 16), z3 = __uint_as_float(zv[q][s].y & 0xffff0000u);
                    const f32x4 ov = o[q][s] * rs * gwv[s];
                    u32x2 w; w.x = pk_bf16(ov[0] * silu_fast(z0), ov[1] * silu_fast(z1)); w.y = pk_bf16(ov[2] * silu_fast(z2), ov[3] * silu_fast(z3));
                    *(u32x2*)(mr + s * 16) = w;
                }
            }
        }
    }
}

#define XB_TMO      128
#define XB_XCNT(j)  (256  + 64 * (j))
#define XB_XSUB(j)  (1280 + 64 * (j))
#define XB_XGEN(j)  (2304 + 64 * (j))
#define XB_TOP      3328
#define XB_TOPGEN   3392
#define XCD_BAR_WORDS 3456
#define XB_SPIN_CAP (1u << 20)
DI unsigned xb_ld(unsigned* p)              { return __hip_atomic_load(p, __ATOMIC_RELAXED, __HIP_MEMORY_SCOPE_AGENT); }
DI unsigned xb_add(unsigned* p, unsigned v) { return __hip_atomic_fetch_add(p, v, __ATOMIC_RELAXED, __HIP_MEMORY_SCOPE_AGENT); }
DI unsigned xb_xcc_id() { return (unsigned)__builtin_amdgcn_s_getreg((3 << 11) | 20) & 0xFu; }
#define XB_SPIN(cond, bar) do { unsigned _sp = 0; while (cond) { __builtin_amdgcn_s_sleep(1); \
    if ((++_sp & 255u) == 0u) { if (xb_ld(&(bar)[XB_TMO])) break; if (_sp > XB_SPIN_CAP) { atomicAdd(&(bar)[XB_TMO], 1u); break; } } } } while (0)
struct XcdBarrier { unsigned* bar; unsigned x; volatile LAS unsigned* st; };
DI XcdBarrier xcd_barrier_post(unsigned* bar, volatile LAS unsigned* st) {
    XcdBarrier b; b.bar = bar; b.x = xb_xcc_id(); b.st = st;
    if (threadIdx.x == 0) (void)xb_add(&bar[XB_XCNT(b.x)], 1u);
    return b;
}
DI void xcd_barrier_complete(unsigned* bar, unsigned x, unsigned& nloc, unsigned& nx) {
    const unsigned G = gridDim.x * gridDim.y * gridDim.z;
    unsigned sum, cnt, mine, sp = 0u;
    for (;;) {
        sum = 0u; cnt = 0u; mine = 0u;
#pragma unroll
        for (unsigned j = 0; j < 16; ++j) { const unsigned c = xb_ld(&bar[XB_XCNT(j)]); sum += c; cnt += (c > 0u) ? 1u : 0u; mine = (j == x) ? c : mine; }
        if (sum == G) break;
        __builtin_amdgcn_s_sleep(1);
        if ((++sp & 255u) == 0u) { if (xb_ld(&bar[XB_TMO])) break; if (sp > XB_SPIN_CAP) { atomicAdd(&bar[XB_TMO], 1u); break; } }
    }
    nloc = mine > 0u ? mine : 1u; nx = cnt > 0u ? cnt : 1u;
}
DI void xcd_barrier(const XcdBarrier& b) {
    asm volatile("s_waitcnt vmcnt(0)" ::: "memory");
    __syncthreads();
    if (threadIdx.x == 0) {
        unsigned* bar = b.bar;
        asm volatile("" : "+s"(bar));
        __builtin_amdgcn_s_waitcnt(0);
        unsigned nloc = b.st[0], nx = b.st[1];
        if (nloc == 0u) { xcd_barrier_complete(bar, b.x, nloc, nx); b.st[0] = nloc; b.st[1] = nx; }
        const unsigned old = xb_add(&bar[XB_XSUB(b.x)], 1u);
        const unsigned gen = old / nloc;
        if (old + 1u == (gen + 1u) * nloc) {
            __builtin_amdgcn_fence(__ATOMIC_RELEASE, "agent");
            asm volatile("s_waitcnt vmcnt(0)" ::: "memory");
            const unsigned og = xb_add(&bar[XB_TOP], 1u);
            const unsigned tg = og / nx;
            if (og + 1u == (tg + 1u) * nx) xb_add(&bar[XB_TOPGEN], 1u);
            else XB_SPIN(xb_ld(&bar[XB_TOPGEN]) == tg, bar);
            __builtin_amdgcn_fence(__ATOMIC_ACQUIRE, "agent");
            xb_add(&bar[XB_XGEN(b.x)], 1u);
            asm volatile("s_waitcnt vmcnt(0)" ::: "memory");
        } else {
            XB_SPIN(xb_ld(&bar[XB_XGEN(b.x)]) == gen, bar);
            __builtin_amdgcn_fence(__ATOMIC_ACQUIRE, "agent");
            asm volatile("s_waitcnt vmcnt(0)" ::: "memory");
        }
    }
    __syncthreads();
}

__global__ void __launch_bounds__(512) mega(Params p) {
    extern __shared__ __attribute__((aligned(16))) unsigned char smem[];
    cg::grid_group grid = cg::this_grid();
    LAS unsigned char* lds = (LAS unsigned char*)smem;
    volatile LAS unsigned* xst = (volatile LAS unsigned*)(lds + LDS_BYTES - 16);
    if (threadIdx.x == 0) { xst[0] = 0u; xst[1] = 0u; }
    __syncthreads();
    const XcdBarrier xb = xcd_barrier_post((unsigned*)(ws_fresh(p.ws) + OFF_BAR), xst);

    phase_weights(p, smem);
    row_phase<0>(p, 0, 0, smem);
    if (p.ws == nullptr) grid.sync();
    xcd_barrier(xb);
    for (int l = 0; l < 2; ++l) {
        {
            pg8::Gemm g{(const bf16_t*)(ws_fresh(p.ws) + OFF_XB), (const bf16_t*)(ws_fresh(p.ws) + OFF_WIN + l * SZ_WIN), TT, 3584, 1024};
            pg8::StaticOrder S; S.init(TT, 3584, 1024, gridDim.x, bid_fresh());
            EpiG1 e{(const float*)(ws_fresh(p.ws) + OFF_RSTD), (bf16_t*)(ws_fresh(p.ws) + OFF_PQKV), (bf16_t*)(ws_fresh(p.ws) + OFF_PSC), (bf16_t*)(ws_fresh(p.ws) + OFF_PZ)};
            pg8::gemm_phase(lds, g, S, e);
        }
        xcd_barrier(xb);
        phase_chunk_scan(p, l, smem, lds);
        xcd_barrier(xb);
        phase_out(p, l);
        xcd_barrier(xb);
        {
            pg8::Gemm g{(const bf16_t*)(p.out + O_Y), (const bf16_t*)(ws_fresh(p.ws) + OFF_WO + l * SZ_WO), TT, 1024, 1024};
            pg8::SplitOrder S; S.init(1024, 1024, gridDim.x, bid_fresh());
            EpiRawSplit e{(bf16_t*)(ws_fresh(p.ws) + OFF_RAW), (float*)(ws_fresh(p.ws) + OFF_PZ)};
            pg8::gemm_phase(lds, g, S, e);
        }
        xcd_barrier(xb);
        row_phase<1>(p, l, 0, smem);
        xcd_barrier(xb);
        {
            pg8::Gemm g{(const bf16_t*)(ws_fresh(p.ws) + OFF_XB), (const bf16_t*)(ws_fresh(p.ws) + OFF_WGU + l * SZ_WGU), TT, 5632, 1024};
            pg8::StaticOrder S; S.init(TT, 5632, 1024, gridDim.x, bid_fresh());
            EpiGU e{(const float*)(ws_fresh(p.ws) + OFF_RSTD), (bf16_t*)(ws_fresh(p.ws) + OFF_ACT)};
            pg8::gemm_phase(lds, g, S, e);
        }
        xcd_barrier(xb);
        {
            pg8::Gemm g{(const bf16_t*)(ws_fresh(p.ws) + OFF_ACT), (const bf16_t*)(ws_fresh(p.ws) + OFF_WD + l * SZ_WD), TT, 1024, DFF};
            pg8::SplitOrder S; S.init(1024, DFF, gridDim.x, bid_fresh());
            EpiRawSplit e{(bf16_t*)(ws_fresh(p.ws) + OFF_RAW), (float*)(ws_fresh(p.ws) + OFF_PZ)};
            pg8::gemm_phase(lds, g, S, e);
        }
        xcd_barrier(xb);
        if (l == 0) { row_phase<2>(p, 0, 1, smem); xcd_barrier(xb); }
        else row_phase<3>(p, 1, 0, smem);
    }
}

extern "C" void kernel_launch(void* const* d_in, const int* in_sizes, int n_in, void* d_out, int out_size, void* d_ws, size_t ws_size,
                              hipStream_t stream) {
    static int grid_blocks = 0;
    if (!grid_blocks) {
        int dev = 0, cus = 0, per_cu = 0;
        hipGetDevice(&dev);
        hipDeviceGetAttribute(&cus, hipDeviceAttributeMultiprocessorCount, dev);
        hipFuncSetAttribute((const void*)mega, hipFuncAttributeMaxDynamicSharedMemorySize, LDS_BYTES);
        hipOccupancyMaxActiveBlocksPerMultiprocessor(&per_cu, mega, 512, LDS_BYTES);
        if (per_cu > 1) per_cu = 1;
        grid_blocks = cus * per_cu;
        if (grid_blocks < 128) { fprintf(stderr, "unexpected occupancy: cus=%d per_cu=%d\n", cus, per_cu); }
    }
    if (ws_size < WS_NEED) { fprintf(stderr, "workspace too small: %zu < %zu\n", ws_size, (size_t)WS_NEED); return; }
    Params p{};
    const float* const* in = (const float* const*)d_in;
    p.xp = in[0]; p.xs = in[1]; p.cache_conv = in[2]; p.state0 = in[3]; p.cache_sc = in[4]; p.n_mix_pre = in[5]; p.w_in = in[6];
    p.conv_w = in[7]; p.a_log = in[8]; p.dt_bias = in[9]; p.gdn_nw = in[10]; p.conv_sc_w = in[11]; p.w_o = in[12]; p.n_mix_post = in[13];
    p.n_ffn_pre = in[14]; p.w_gate = in[15]; p.w_up = in[16]; p.w_down = in[17]; p.n_ffn_post = in[18];
    p.out = (float*)d_out; p.ws = (unsigned char*)d_ws;
    hipMemsetAsync((unsigned char*)d_ws + OFF_BAR, 0, 32768, stream);
    void* args[] = {&p};
    hipError_t e = hipLaunchCooperativeKernel((const void*)mega, dim3(grid_blocks), dim3(512), args, LDS_BYTES, stream);
    if (e != hipSuccess) fprintf(stderr, "cooperative launch failed: %s (grid %d)\n", hipGetErrorString(e), grid_blocks);
}
```
